# Optimizing an MI355X kernel written in HIP

```python
import jax, jax.numpy as jnp
from jax import lax
import numpy as np

D_MODEL = 2048
BATCH = 1
SEQ = 16384
DEPTH = 2

CHUNK = 64
D_MIX = D_MODEL
D_CONV = D_MIX // 2
D_GLA = D_MIX - D_CONV
N_GLA_HEADS = 4
HEAD_V = D_GLA // N_GLA_HEADS
HEAD_K = HEAD_V // 2
D_QK = N_GLA_HEADS * HEAD_K
GATE_RANK = 16
GATE_TAU = 16.0
CONV_WIDTH = 3
D_FF = ((int(8 * D_MODEL / 3) + 255) // 256) * 256
FFN_RES_SCALE = 0.5
EPS = 1e-6
IN_COLS = 3 * D_CONV + 2 * D_QK + 2 * D_GLA + GATE_RANK

kernel_name = "hymba_conv_gla_macaron_trunk"


def _rmsnorm(x, g):
    xf = x.astype(jnp.float32)
    y = xf * lax.rsqrt(jnp.mean(xf * xf, axis=-1, keepdims=True) + EPS)
    return (y * g.astype(jnp.float32)).astype(x.dtype)


def _swiglu(h, w_gate, w_up, w_down):
    return (jax.nn.silu(h @ w_gate) * (h @ w_up)) @ w_down


def _causal_dwconv(u, w):
    c = u.shape[-1]
    return lax.conv_general_dilated(
        u, w[:, None, :].astype(u.dtype), window_strides=(1,),
        padding=[(CONV_WIDTH - 1, 0)], dimension_numbers=("NWC", "WIO", "NWC"),
        feature_group_count=c)


def _gla_chunk_causal(q, k, v, log_a):
    b, t, h, _ = q.shape
    nc = t // CHUNK

    def to_chunks(a):
        return a.reshape(b, nc, CHUNK, h, a.shape[-1]).transpose(1, 0, 3, 2, 4).astype(jnp.float32)

    qc, kc, vc, ac = to_chunks(q), to_chunks(k), to_chunks(v), to_chunks(log_a)

    def step(state, inp):
        qi, ki, vi, ai = inp
        bcum = jnp.cumsum(ai, axis=2)
        o_inter = jnp.einsum("bhtk,bhkv->bhtv", qi * jnp.exp(bcum), state)
        decay = jnp.exp(-jnp.abs(bcum[:, :, :, None, :] - bcum[:, :, None, :, :]))
        scores = jnp.einsum("bhtk,bhsk,bhtsk->bhts", qi, ki, decay)
        o_intra = jnp.einsum("bhts,bhsv->bhtv", scores, vi)
        blast = bcum[:, :, -1:, :]
        new_state = jnp.exp(blast[:, :, 0, :])[..., None] * state + jnp.einsum(
            "bhsk,bhsv->bhkv", ki * jnp.exp(blast - bcum), vi)
        return new_state, o_inter + o_intra

    s0 = jnp.zeros((b, h, q.shape[-1], v.shape[-1]), jnp.float32)
    _, out = lax.scan(step, s0, (qc, kc, vc, ac))
    return out.transpose(1, 0, 3, 2, 4).reshape(b, t, h, v.shape[-1])


def _token_mixing(h, w_in, conv_w, gate_w2, gate_b, gla_norm, w_out):
    b, t, _ = h.shape
    proj = h @ w_in
    sizes = (D_CONV, D_CONV, D_CONV, D_QK, D_QK, D_GLA, D_GLA, GATE_RANK)
    cuts = [int(c) for c in np.cumsum(sizes)[:-1]]
    xv, gb, gc, q, k, v, g, zl = jnp.split(proj, cuts, axis=-1)

    y_conv = gb * _causal_dwconv(gc * xv, conv_w)

    log_a = jax.nn.log_sigmoid((zl @ gate_w2 + gate_b).astype(jnp.float32)) / GATE_TAU
    qh = q.reshape(b, t, N_GLA_HEADS, HEAD_K) * (HEAD_K ** -0.5)
    kh = k.reshape(b, t, N_GLA_HEADS, HEAD_K)
    vh = v.reshape(b, t, N_GLA_HEADS, HEAD_V)
    o = _gla_chunk_causal(qh, kh, vh, log_a.reshape(b, t, N_GLA_HEADS, HEAD_K))
    o = _rmsnorm(o, gla_norm).astype(h.dtype).reshape(b, t, D_GLA)
    y_gla = o * jax.nn.silu(g)

    return jnp.concatenate([y_conv, y_gla], axis=-1) @ w_out


def setup_inputs(seed: int = 0) -> dict:
    key = jax.random.key(seed)
    ks = jax.random.split(key, 20)
    f32 = jnp.float32

    def nrm(k, shape, fan_in):
        return jax.random.normal(k, shape, f32) * (fan_in ** -0.5)

    def gain(k, shape):
        return 1.0 + 0.02 * jax.random.normal(k, shape, f32)

    return {
        "x": jax.random.normal(ks[0], (BATCH, SEQ, D_MODEL), f32),
        "ffn1_norm": gain(ks[1], (DEPTH, D_MODEL)),
        "ffn1_w_gate": nrm(ks[2], (DEPTH, D_MODEL, D_FF), D_MODEL),
        "ffn1_w_up": nrm(ks[3], (DEPTH, D_MODEL, D_FF), D_MODEL),
        "ffn1_w_down": nrm(ks[4], (DEPTH, D_FF, D_MODEL), D_FF),
        "mix_norm": gain(ks[5], (DEPTH, D_MODEL)),
        "w_in": nrm(ks[6], (DEPTH, D_MODEL, IN_COLS), D_MODEL),
        "conv_w": nrm(ks[7], (DEPTH, CONV_WIDTH, D_CONV), CONV_WIDTH),
        "gate_w2": nrm(ks[8], (DEPTH, GATE_RANK, D_QK), GATE_RANK),
        "gate_b": 0.01 * jax.random.normal(ks[9], (DEPTH, D_QK), f32),
        "gla_norm": gain(ks[10], (DEPTH, HEAD_V)),
        "w_out": nrm(ks[11], (DEPTH, D_MIX, D_MODEL), D_MIX),
        "ffn2_norm": gain(ks[12], (DEPTH, D_MODEL)),
        "ffn2_w_gate": nrm(ks[13], (DEPTH, D_MODEL, D_FF), D_MODEL),
        "ffn2_w_up": nrm(ks[14], (DEPTH, D_MODEL, D_FF), D_MODEL),
        "ffn2_w_down": nrm(ks[15], (DEPTH, D_FF, D_MODEL), D_FF),
        "final_norm": gain(ks[16], (D_MODEL,)),
    }


def reference(x, ffn1_norm, ffn1_w_gate, ffn1_w_up, ffn1_w_down, mix_norm, w_in, conv_w,
              gate_w2, gate_b, gla_norm, w_out, ffn2_norm, ffn2_w_gate, ffn2_w_up,
              ffn2_w_down, final_norm):
    for l in range(DEPTH):
        x = x + FFN_RES_SCALE * _swiglu(_rmsnorm(x, ffn1_norm[l]),
                                        ffn1_w_gate[l], ffn1_w_up[l], ffn1_w_down[l])
        x = x + _token_mixing(_rmsnorm(x, mix_norm[l]), w_in[l], conv_w[l], gate_w2[l],
                              gate_b[l], gla_norm[l], w_out[l])
        x = x + FFN_RES_SCALE * _swiglu(_rmsnorm(x, ffn2_norm[l]),
                                        ffn2_w_gate[l], ffn2_w_up[l], ffn2_w_down[l])
    return _rmsnorm(x, final_norm)
```

```cpp
#include <hip/hip_runtime.h>
#include <hip/hip_cooperative_groups.h>
#include <cstdio>
#include <cstdint>
namespace pg8 {
#define PG8_LAS __attribute__((address_space(3)))
typedef unsigned short bf16_t;
typedef short bf16x8 __attribute__((ext_vector_type(8)));
typedef float f32x4 __attribute__((ext_vector_type(4)));
typedef unsigned u32x4 __attribute__((ext_vector_type(4)));
constexpr int BM = 256, BK = 64, HALF = 128, HTB = HALF * BK * 2  , STAGE_BYTES = 8 * HTB, NXCD = 8, WGM = 8;

__host__ __device__ __forceinline__ int lds_byte(int r, int c) { const int st = (r >> 4) * 2 + (c >> 5), rr = r & 15, cc = c & 31, ob = rr * 64 + cc * 2; return st * 1024 + (ob ^ (((ob >> 9) & 1) << 5)); }
__host__ __device__ __forceinline__ void stage_rc(int b, int& R, int& C) { const int st = b / 1024, sb = b % 1024, swz = sb ^ (((sb >> 9) & 1) << 5); R = (st >> 1) * 16 + swz / 64; C = (st & 1) * 32 + (swz % 64) / 2; }
__host__ __device__ __forceinline__ int perm32(int rho) { const int n = rho >> 4, i = rho & 15; return 8 * (i >> 2) + 4 * n + (i & 3); }

struct Unit { int pm, pn; };
struct Gemm { const bf16_t* A; const bf16_t* Bt; int M, N, K; };

struct StaticOrder {
    int nM, nN, nwg, G, c;
    __host__ __device__ void init(int M, int N, int G_, int c_) { nM = M / BM; nN = N / BM; nwg = nM * nN; G = G_; c = c_; }
    __host__ __device__ bool next(int i, Unit& u) const {
        const long L = (long)i * G + c; if (L >= nwg) return false;
        int wgid = (int)L; { const int q = nwg / NXCD, r = nwg % NXCD, xcd = wgid % NXCD, off = wgid / NXCD; wgid = (xcd < r ? xcd * (q + 1) : r * (q + 1) + (xcd - r) * q) + off; }
        const int nig = WGM * nN, gid = wgid / nig, fm = gid * WGM, gsz = (nM - fm) < WGM ? (nM - fm) : WGM;
        u.pm = fm + ((wgid % nig) % gsz); u.pn = (wgid % nig) / gsz; return true;
    }
    __device__ __forceinline__ void a_ready(const Unit&) const {}
    __device__ __forceinline__ void done(const Unit&) const {}
};
__device__ __forceinline__ unsigned cvt_pk_bf16(float lo, float hi) { unsigned r; asm volatile("v_cvt_pk_bf16_f32 %0, %1, %2" : "=v"(r) : "v"(lo), "v"(hi)); return r; }
typedef float f32x2 __attribute__((ext_vector_type(2)));
__device__ __forceinline__ float silu_f(float g) { return g * __builtin_amdgcn_rcpf(1.0f + __expf(-g)); }
struct EpiSwiglu {
    static constexpr bool PERM = true, AFTER_DRAIN = false;
    bf16_t* H; int ldh;
    __device__ __forceinline__ void prefetch(const Unit&, int, int, PG8_LAS unsigned char*) const {}
    __device__ __forceinline__ void operator()(const f32x4 (&acc)[2][2][4][2], const Unit& u, int wr, int wc, int fr, int fq, PG8_LAS unsigned char*) const {
        const int row0 = u.pm * BM + wr * 64 + fr, col0 = u.pn * HALF + wc * 32 + 8 * fq;
#pragma unroll
        for (int ai = 0; ai < 2; ++ai)
#pragma unroll
            for (int m = 0; m < 4; ++m) { bf16_t* rowp = H + (size_t)(row0 + ai * HALF + m * 16) * ldh + col0;
                const f32x4 g0 = acc[ai][0][m][0], g1 = acc[ai][0][m][1], u0 = acc[ai][1][m][0], u1 = acc[ai][1][m][1];
                u32x4 w;
                w.x = cvt_pk_bf16(silu_f(g0[0]) * u0[0], silu_f(g0[1]) * u0[1]); w.y = cvt_pk_bf16(silu_f(g0[2]) * u0[2], silu_f(g0[3]) * u0[3]);
                w.z = cvt_pk_bf16(silu_f(g1[0]) * u1[0], silu_f(g1[1]) * u1[1]); w.w = cvt_pk_bf16(silu_f(g1[2]) * u1[2], silu_f(g1[3]) * u1[3]);
                *(u32x4*)rowp = w; }
    }
};
struct EpiStoreBf16 {
    static constexpr bool PERM = true, AFTER_DRAIN = false;
    bf16_t* O; int ldc;
    __device__ __forceinline__ void prefetch(const Unit&, int, int, PG8_LAS unsigned char*) const {}
    __device__ __forceinline__ void operator()(const f32x4 (&acc)[2][2][4][2], const Unit& u, int wr, int wc, int fr, int fq, PG8_LAS unsigned char*) const {
        const int row0 = u.pm * BM + wr * 64 + fr, col0 = u.pn * BM + wc * 32 + 8 * fq;
#pragma unroll
        for (int ai = 0; ai < 2; ++ai)
#pragma unroll
            for (int m = 0; m < 4; ++m) { bf16_t* rowp = O + (size_t)(row0 + ai * HALF + m * 16) * ldc + col0;
#pragma unroll
                for (int bj = 0; bj < 2; ++bj) { const f32x4 v0 = acc[ai][bj][m][0], v1 = acc[ai][bj][m][1];
                    u32x4 w; w.x = cvt_pk_bf16(v0[0], v0[1]); w.y = cvt_pk_bf16(v0[2], v0[3]); w.z = cvt_pk_bf16(v1[0], v1[1]); w.w = cvt_pk_bf16(v1[2], v1[3]);
                    *(u32x4*)(rowp + bj * HALF) = w; } }
    }
};
struct EpiResid {
    static constexpr bool PERM = true, AFTER_DRAIN = false;
    bf16_t* xb; int ldc; float scale;
    __device__ __forceinline__ void prefetch(const Unit&, int, int, PG8_LAS unsigned char*) const {}
    __device__ __forceinline__ void operator()(const f32x4 (&acc)[2][2][4][2], const Unit& u, int wr, int wc, int fr, int fq, PG8_LAS unsigned char*) const {
        const int row0 = u.pm * BM + wr * 64 + fr, col0 = u.pn * BM + wc * 32 + 8 * fq;
#pragma unroll
        for (int ai = 0; ai < 2; ++ai)
#pragma unroll
        for (int mh = 0; mh < 2; ++mh) {
            u32x4 r[2][2];
#pragma unroll
            for (int m2 = 0; m2 < 2; ++m2) { const size_t off = (size_t)(row0 + ai * HALF + (2 * mh + m2) * 16) * ldc + col0;
#pragma unroll
                for (int bj = 0; bj < 2; ++bj) r[m2][bj] = *(const u32x4*)(xb + off + bj * HALF); }
#pragma unroll
            for (int m2 = 0; m2 < 2; ++m2) { const int m = 2 * mh + m2; const size_t off = (size_t)(row0 + ai * HALF + m * 16) * ldc + col0;
#pragma unroll
                for (int bj = 0; bj < 2; ++bj) {
                    const u32x4 q = r[m2][bj]; f32x4 o0, o1;
                    o0[0] = __uint_as_float(q.x << 16); o0[1] = __uint_as_float(q.x & 0xffff0000u); o0[2] = __uint_as_float(q.y << 16); o0[3] = __uint_as_float(q.y & 0xffff0000u);
                    o1[0] = __uint_as_float(q.z << 16); o1[1] = __uint_as_float(q.z & 0xffff0000u); o1[2] = __uint_as_float(q.w << 16); o1[3] = __uint_as_float(q.w & 0xffff0000u);
                    o0 = o0 + acc[ai][bj][m][0] * scale; o1 = o1 + acc[ai][bj][m][1] * scale;
                    u32x4 w; w.x = cvt_pk_bf16(o0[0], o0[1]); w.y = cvt_pk_bf16(o0[2], o0[3]); w.z = cvt_pk_bf16(o1[0], o1[1]); w.w = cvt_pk_bf16(o1[2], o1[3]);
                    *(u32x4*)(xb + off + bj * HALF) = w; } }
            asm volatile("" ::: "memory"); }
    }
};
template <class Epi, class Sched, bool ALIGN_EPI = false, bool SP2 = false>
__device__ __forceinline__ void gemm_phase(PG8_LAS unsigned char* lds, const Gemm g, const Sched& S, const Epi& E) {
    int tid_ = threadIdx.x; asm volatile("" : "+v"(tid_)); const int tid = tid_, wid = __builtin_amdgcn_readfirstlane(tid >> 6), lane = tid & 63, wr = wid >> 2, wc = wid & 3, fr = lane & 15, fq = lane >> 4;
    const int K = g.K, nt = K / BK;
    unsigned voffA[2], voffB[2];
#pragma unroll
    for (int i = 0; i < 2; ++i) { int R, C; stage_rc(tid * 16 + i * 8192, R, C); const int Rb = Epi::PERM ? ((R & ~31) + perm32(R & 31)) : R;
        voffA[i] = (unsigned)(R * K + C) * 2u; voffB[i] = (unsigned)(Rb * K + C) * 2u; }
    const size_t kstep = (size_t)(BK * 2);
    const size_t hstep = (size_t)HALF * K * 2;
    const size_t tstep = 2 * hstep;
    const unsigned ldsw = (unsigned)wid * 1024u;
    const int aoff = lds_byte(wr * 64 + fr, fq * 8), boff = lds_byte(wc * 32 + fr, fq * 8);
#define PG8_SA(b, h) (((b) * 2 + (h)) * HTB)
#define PG8_SB(b, h) ((4 + (b) * 2 + (h)) * HTB)
#define PG8_STAGE(bufoff, gbase, voff) do { _Pragma("unroll") for (int _i = 0; _i < 2; ++_i) \
        __builtin_amdgcn_global_load_lds((const unsigned*)((const char*)(gbase) + (voff)[_i]), (PG8_LAS unsigned*)(lds + (bufoff) + ldsw + _i * 8192), 16, 0, 0); } while (0)
#define PG8_LDA(dst, b, h) do { _Pragma("unroll") for (int m = 0; m < 4; ++m) _Pragma("unroll") for (int k = 0; k < 2; ++k) dst[m][k] = *(const PG8_LAS bf16x8*)(lds + PG8_SA(b, h) + aoff + m * 2048 + k * 1024); } while (0)
#define PG8_LDB(dst, b, h) do { _Pragma("unroll") for (int n = 0; n < 2; ++n) _Pragma("unroll") for (int k = 0; k < 2; ++k) dst[n][k] = *(const PG8_LAS bf16x8*)(lds + PG8_SB(b, h) + boff + n * 2048 + k * 1024); } while (0)
#define PG8_MMA(ai, bj, At, Bt) do { __builtin_amdgcn_s_setprio(1); _Pragma("unroll") for (int m = 0; m < 4; ++m) _Pragma("unroll") for (int n = 0; n < 2; ++n) _Pragma("unroll") for (int k = 0; k < 2; ++k) \
        acc[ai][bj][m][n] = __builtin_amdgcn_mfma_f32_16x16x32_bf16(Bt[n][k], At[m][k], acc[ai][bj][m][n], 0, 0, 0); __builtin_amdgcn_s_setprio(0); } while (0)
#define PG8_WAIT_V(n) asm volatile("s_waitcnt vmcnt(" #n ")" ::: "memory")
#define PG8_WAIT_L(n) asm volatile("s_waitcnt lgkmcnt(" #n ")" ::: "memory")
#define PG8_BAR __builtin_amdgcn_s_barrier()
#define PG8_SCHED __builtin_amdgcn_sched_barrier(0)
    Unit cur, nxt; int ui = 0;
    if (!S.next(0, cur)) return;
    f32x4 acc[2][2][4][2];
#pragma unroll
    for (int a = 0; a < 2; ++a)
#pragma unroll
        for (int b = 0; b < 2; ++b)
#pragma unroll
            for (int m = 0; m < 4; ++m)
#pragma unroll
                for (int n = 0; n < 2; ++n) acc[a][b][m][n] = (f32x4){0.f, 0.f, 0.f, 0.f};
    bf16x8 At[4][2], B0[2][2], B1[2][2];
    const char* cA = (const char*)g.A + (size_t)cur.pm * tstep; const char* cB = (const char*)g.Bt + (size_t)cur.pn * tstep;
    S.a_ready(cur);
    if constexpr (SP2) {
        PG8_STAGE(PG8_SB(0, 0), cB, voffB); PG8_STAGE(PG8_SB(0, 1), cB + hstep, voffB); PG8_STAGE(PG8_SA(0, 0), cA, voffA); PG8_STAGE(PG8_SA(0, 1), cA + hstep, voffA);
        if (wr == 1) PG8_BAR;
        PG8_WAIT_V(2); PG8_BAR;
        PG8_STAGE(PG8_SB(1, 0), cB + kstep, voffB); PG8_STAGE(PG8_SA(1, 0), cA + kstep, voffA); PG8_STAGE(PG8_SB(1, 1), cB + hstep + kstep, voffB);
        PG8_WAIT_V(6); PG8_BAR;
    } else {
        PG8_STAGE(PG8_SB(0, 0), cB, voffB); PG8_STAGE(PG8_SA(0, 0), cA, voffA); PG8_STAGE(PG8_SB(0, 1), cB + hstep, voffB); PG8_STAGE(PG8_SA(0, 1), cA + hstep, voffA);
        if (wr == 1) PG8_BAR;
        PG8_WAIT_V(4); PG8_BAR;
        PG8_STAGE(PG8_SB(1, 0), cB + kstep, voffB); PG8_STAGE(PG8_SA(1, 0), cA + kstep, voffA); PG8_STAGE(PG8_SB(1, 1), cB + hstep + kstep, voffB);
        PG8_WAIT_V(6); PG8_BAR;
    }
    for (;;) {
        const bool has_next = S.next(ui + 1, nxt);
        const char* nA = has_next ? (const char*)g.A + (size_t)nxt.pm * tstep : cA; const char* nB = has_next ? (const char*)g.Bt + (size_t)nxt.pn * tstep : cB;
        for (int t = 0; t < nt; t += 2) {
            const bool last = (t == nt - 2);
            const char* a1 = cA + (size_t)(t + 1) * kstep;
            const char* a2 = last ? nA : cA + (size_t)(t + 2) * kstep; const char* b2 = last ? nB : cB + (size_t)(t + 2) * kstep;
            const char* a3 = a2 + kstep; const char* b3 = b2 + kstep;
            if (last && has_next) S.a_ready(nxt);
            if (last) E.prefetch(cur, wid, lane, lds + STAGE_BYTES + 1024);
            if constexpr (SP2) {
            PG8_LDB(B0, 0, 0); PG8_LDB(B1, 0, 1); PG8_SCHED; PG8_LDA(At, 0, 0); PG8_STAGE(PG8_SA(1, 1), a1 + hstep, voffA);
            PG8_WAIT_V(8); PG8_WAIT_L(0); PG8_BAR; PG8_MMA(0, 0, At, B0); PG8_MMA(0, 1, At, B1); PG8_BAR; PG8_SCHED;
            PG8_LDA(At, 0, 1); PG8_STAGE(PG8_SB(0, 0), b2, voffB); PG8_STAGE(PG8_SB(0, 1), b2 + hstep, voffB); PG8_STAGE(PG8_SA(0, 0), a2, voffA);
            PG8_WAIT_V(8); PG8_WAIT_L(0); PG8_BAR; PG8_MMA(1, 0, At, B0); PG8_MMA(1, 1, At, B1); PG8_BAR; PG8_SCHED;
            PG8_LDB(B0, 1, 0); PG8_LDB(B1, 1, 1); PG8_SCHED; PG8_LDA(At, 1, 0); PG8_STAGE(PG8_SA(0, 1), a2 + hstep, voffA);
            PG8_WAIT_V(8); PG8_WAIT_L(0); PG8_BAR; PG8_MMA(0, 0, At, B0); PG8_MMA(0, 1, At, B1); PG8_BAR; PG8_SCHED;
            PG8_LDA(At, 1, 1); PG8_STAGE(PG8_SB(1, 0), b3, voffB); PG8_STAGE(PG8_SB(1, 1), b3 + hstep, voffB); PG8_STAGE(PG8_SA(1, 0), a3, voffA);
            PG8_WAIT_V(8); PG8_WAIT_L(0); PG8_BAR; PG8_MMA(1, 0, At, B0); PG8_MMA(1, 1, At, B1); PG8_BAR; PG8_SCHED;
            } else {
            PG8_LDB(B0, 0, 0); PG8_SCHED; PG8_LDA(At, 0, 0); PG8_STAGE(PG8_SA(1, 1), a1 + hstep, voffA);
            PG8_WAIT_L(8); PG8_BAR; PG8_WAIT_L(0); PG8_MMA(0, 0, At, B0); PG8_BAR; PG8_SCHED;
            PG8_LDB(B1, 0, 1); PG8_STAGE(PG8_SB(0, 0), b2, voffB);
            PG8_BAR; PG8_WAIT_L(0); PG8_MMA(0, 1, At, B1); PG8_BAR;
            PG8_LDA(At, 0, 1); PG8_STAGE(PG8_SA(0, 0), a2, voffA);
            PG8_BAR; PG8_WAIT_L(0); PG8_MMA(1, 0, At, B0); PG8_BAR; PG8_SCHED;
            PG8_STAGE(PG8_SB(0, 1), b2 + hstep, voffB);
            PG8_WAIT_V(6); PG8_BAR; PG8_MMA(1, 1, At, B1); PG8_BAR;
            PG8_LDB(B0, 1, 0); PG8_SCHED; PG8_LDA(At, 1, 0); PG8_STAGE(PG8_SA(0, 1), a2 + hstep, voffA);
            PG8_WAIT_L(8); PG8_BAR; PG8_WAIT_L(0); PG8_MMA(0, 0, At, B0); PG8_BAR; PG8_SCHED;
            PG8_LDB(B1, 1, 1); PG8_STAGE(PG8_SB(1, 0), b3, voffB);
            PG8_BAR; PG8_WAIT_L(0); PG8_MMA(0, 1, At, B1); PG8_BAR;
            PG8_LDA(At, 1, 1); PG8_STAGE(PG8_SA(1, 0), a3, voffA);
            PG8_BAR; PG8_WAIT_L(0); PG8_MMA(1, 0, At, B0); PG8_BAR; PG8_SCHED;
            PG8_STAGE(PG8_SB(1, 1), b3 + hstep, voffB);
            PG8_WAIT_V(6); PG8_BAR; PG8_MMA(1, 1, At, B1); PG8_BAR;
            }
        }
        if constexpr (ALIGN_EPI) { if (wr == 0) PG8_BAR; }
        if constexpr (!Epi::AFTER_DRAIN) { E(acc, cur, wr, wc, fr, fq, lds + STAGE_BYTES + 1024); S.done(cur); }
        if (!has_next) break;
#pragma unroll
        for (int a = 0; a < 2; ++a)
#pragma unroll
            for (int b = 0; b < 2; ++b)
#pragma unroll
                for (int m = 0; m < 4; ++m)
#pragma unroll
                    for (int n = 0; n < 2; ++n) acc[a][b][m][n] = (f32x4){0.f, 0.f, 0.f, 0.f};
        cur = nxt; cA = nA; cB = nB; ++ui;
        if constexpr (ALIGN_EPI) { if (wr == 1) PG8_BAR; }
    }
    PG8_WAIT_V(0);
    if constexpr (!ALIGN_EPI) { if (wr == 0) PG8_BAR; }
    PG8_BAR;
    if constexpr (Epi::AFTER_DRAIN) { E.fused(acc, cur, wr, wc, fr, fq, lds, wid, lane); S.done(cur); }
#undef PG8_SA
#undef PG8_SB
#undef PG8_STAGE
#undef PG8_LDA
#undef PG8_LDB
#undef PG8_MMA
#undef PG8_WAIT_V
#undef PG8_WAIT_L
#undef PG8_BAR
#undef PG8_SCHED
}
}

namespace cg = cooperative_groups;
#define LAS __attribute__((address_space(3)))
typedef unsigned short bf16;
typedef unsigned u32x4 __attribute__((ext_vector_type(4)));
typedef unsigned u32x2 __attribute__((ext_vector_type(2)));
typedef float f32x4 __attribute__((ext_vector_type(4)));
typedef float f32x2 __attribute__((ext_vector_type(2)));
typedef short bf16x8 __attribute__((ext_vector_type(8)));
constexpr int NWAVES = 8, NTHR = 512;
constexpr int T = 16384, D = 2048, FF = 5632, NUP = 2 * FF, NINV = 6160, NIN = 6400;
constexpr int DCONV = 1024, DQK = 512, DGLA = 1024, HK = 128, HV = 256, NH = 4, RANK = 16, CH = 64, NCH = T / CH;
constexpr int C_XV = 0, C_GB = 1024, C_GC = 2048, C_Q = 3072, C_K = 3584, C_V = 4096, C_G = 5120, C_ZL = 6144;
constexpr float EPS = 1e-6f;
constexpr size_t MiB = 1u << 20;
constexpr size_t WS_F1UP = 0, WS_F1DN = 44 * MiB, WS_F2UP = 66 * MiB, WS_F2DN = 110 * MiB, WS_WIN = 132 * MiB, WS_WOUT = 157 * MiB;
constexpr size_t WS_XN = 166 * MiB, WS_H = 230 * MiB  , WS_Y = 430 * MiB, WS_U = 494 * MiB, WS_BC = 558 * MiB, WS_DEC = 590 * MiB, WS_CTL = 590 * MiB + 512 * 1024, CTL_BYTES = 16384, WS_XB = 594 * MiB  , WS_DUMMY = 658 * MiB, WS_END = 722 * MiB;
#ifndef REP_GEMM
#define REP_GEMM 1
#endif
#ifndef REP_CN
#define REP_CN 1
#endif
#ifndef REP_SCAN
#define REP_SCAN 1
#endif
#ifndef REP_GLA
#define REP_GLA 1
#endif
constexpr int LDS_BYTES = 135168;

__device__ __forceinline__ float bflo(unsigned u) { return __uint_as_float(u << 16); }
__device__ __forceinline__ float bfhi(unsigned u) { return __uint_as_float(u & 0xffff0000u); }
__device__ __forceinline__ float bf2f(unsigned short b) { return __uint_as_float(((unsigned)b) << 16); }
__device__ __forceinline__ unsigned pk2(float lo, float hi) { return pg8::cvt_pk_bf16(lo, hi); }
__device__ __forceinline__ float wave_sum(float v) {
#pragma unroll
    for (int o = 1; o < 64; o <<= 1) v += __shfl_xor(v, o);
    return v;
}
#define LDS_WAIT() asm volatile("s_waitcnt lgkmcnt(0)" ::: "memory")

struct Args { const float* in[17]; float* out; unsigned char* ws; };
typedef const Args* ArgP;
struct CvItem { const float* W; int K, N; bf16* WT; int dst_row0, k0, n0; const float* gain; };
__device__ __forceinline__ CvItem cv_decode(ArgP ap, int l, int it) {
    constexpr int I_UP = (D / 64) * (FF / 32);
    constexpr int NB_IN = (NINV + 31) / 32;
    constexpr int I_IN = (D / 64) * NB_IN;
    unsigned char* ws = ap->ws; CvItem c; int r = it;
    if (r < 6 * I_UP) {
        const int which = r / I_UP; r -= which * I_UP;
        const int f = which / 3, w3 = which % 3;
        c.W = (f == 0 ? (w3 == 0 ? ap->in[2] : (w3 == 1 ? ap->in[3] : ap->in[4])) : (w3 == 0 ? ap->in[13] : (w3 == 1 ? ap->in[14] : ap->in[15]))) + (size_t)l * D * FF;
        if (w3 < 2) { const int nblk = FF / 32, kb = r / nblk, nb = r % nblk; c.n0 = nb * 32; c.k0 = kb * 64; c.K = D; c.N = FF;
            c.WT = (bf16*)(ws + (f == 0 ? WS_F1UP : WS_F2UP)); c.dst_row0 = (c.n0 >> 7) * 256 + (c.n0 & 127) + (w3 == 1 ? 128 : 0); c.gain = nullptr; }
        else { const int nblk = D / 32, kb = r / nblk, nb = r % nblk; c.n0 = nb * 32; c.k0 = kb * 64; c.K = FF; c.N = D;
            c.WT = (bf16*)(ws + (f == 0 ? WS_F1DN : WS_F2DN)); c.dst_row0 = c.n0; c.gain = nullptr; }
        return c;
    }
    r -= 6 * I_UP;
    if (r < I_IN) { const int kb = r / NB_IN, nb = r % NB_IN; c.n0 = nb * 32; c.k0 = kb * 64; c.K = D; c.N = NINV; c.W = ap->in[6] + (size_t)l * D * NINV; c.WT = (bf16*)(ws + WS_WIN); c.dst_row0 = c.n0; c.gain = nullptr; return c; }
    r -= I_IN;
    { const int nblk = D / 32, kb = r / nblk, nb = r % nblk; c.n0 = nb * 32; c.k0 = kb * 64; c.K = D; c.N = D; c.W = ap->in[11] + (size_t)l * D * D; c.WT = (bf16*)(ws + WS_WOUT); c.dst_row0 = c.n0; c.gain = nullptr; }
    return c;
}
__device__ __forceinline__ void cv_load(const CvItem& c, int lane, f32x4 (&v)[8]) {
    const int col4 = (lane & 7) * 4; const bool ok = (c.n0 + col4) < c.N;
    const float* p = c.W + (size_t)(c.k0 + (lane >> 3)) * c.N + c.n0 + col4;
#pragma unroll
    for (int i = 0; i < 8; ++i) v[i] = ok ? *(const f32x4*)(p + (size_t)(8 * i) * c.N) : (f32x4){0.f, 0.f, 0.f, 0.f};
}
__device__ __forceinline__ void cv_process(const CvItem& c, int lane, const f32x4 (&v)[8], LAS float* scr) {
    const int col4 = (lane & 7) * 4, r0 = lane >> 3, cc = lane & 7;
    f32x4 g0 = (f32x4){1.f, 1.f, 1.f, 1.f}, g1 = g0;
    if (c.gain) { g0 = *(const f32x4*)(c.gain + c.k0 + 8 * cc); g1 = *(const f32x4*)(c.gain + c.k0 + 8 * cc + 4); }
#pragma unroll
    for (int i = 0; i < 8; ++i) { LAS float* d = scr + (r0 + 8 * i) * 33 + col4; d[0] = v[i][0]; d[1] = v[i][1]; d[2] = v[i][2]; d[3] = v[i][3]; }
    LDS_WAIT(); asm volatile("" ::: "memory");
#pragma unroll
    for (int j = 0; j < 4; ++j) { const int n = (lane >> 3) + 8 * j; const LAS float* s = scr + (8 * cc) * 33 + n;
        u32x4 o; o.x = pk2(s[0 * 33] * g0[0], s[1 * 33] * g0[1]); o.y = pk2(s[2 * 33] * g0[2], s[3 * 33] * g0[3]); o.z = pk2(s[4 * 33] * g1[0], s[5 * 33] * g1[1]); o.w = pk2(s[6 * 33] * g1[2], s[7 * 33] * g1[3]);
        *(u32x4*)(c.WT + (size_t)(c.dst_row0 + n) * c.K + c.k0 + 8 * cc) = o; }
    LDS_WAIT(); asm volatile("" ::: "memory");
}

__device__ __forceinline__ void convert_phase(ArgP ap, int l, LAS unsigned char* lds, int gw, int NGW, int wave, int lane, int gtid, int GT) {
    LAS float* scr = (LAS float*)(lds + wave * 16384);
    constexpr int I_UP = (D / 64) * (FF / 32), NB_IN = (NINV + 31) / 32, I_IN = (D / 64) * NB_IN, I_OUT = (D / 64) * (D / 32);
    constexpr int NITEMS = 6 * I_UP + I_IN + I_OUT;
    unsigned char* ws = ap->ws;
    int it = gw;
    if (it < NITEMS) {
        CvItem cur = cv_decode(ap, l, it); f32x4 v[8]; cv_load(cur, lane, v);
        for (;;) {
            const int nit = it + NGW; const bool more = nit < NITEMS;
            CvItem nxt = cur; f32x4 vn[8];
            if (more) { nxt = cv_decode(ap, l, nit); cv_load(nxt, lane, vn); }
            cv_process(cur, lane, v, scr);
            if (!more) break;
            cur = nxt; it = nit;
#pragma unroll
            for (int i = 0; i < 8; ++i) v[i] = vn[i];
        }
    }
    { u32x4* p = (u32x4*)(ws + WS_WIN + (size_t)(NB_IN * 32) * D * 2); const int n16 = (NIN - NB_IN * 32) * D * 2 / 16;
      for (int i = gtid; i < n16; i += GT) p[i] = (u32x4){0u, 0u, 0u, 0u}; }
}

__device__ __forceinline__ void cast_phase(const float* x, bf16* xb, int gw, int NGW, int lane) {
    for (int m = gw; m < T; m += NGW) {
        const f32x4* xr = (const f32x4*)(x + (size_t)m * D) + lane; u32x2* o = (u32x2*)(xb + (size_t)m * D) + lane;
#pragma unroll
        for (int j = 0; j < 8; ++j) { const f32x4 v = xr[64 * j]; u32x2 w; w.x = pk2(v.x, v.y); w.y = pk2(v.z, v.w); o[64 * j] = w; }
    }
}
__device__ __forceinline__ void norm_phase(const bf16* xb, const float* g, bf16* xn, int gw, int NGW, int lane) {
    f32x4 gv[8];
#pragma unroll
    for (int j = 0; j < 4; ++j) { gv[2 * j] = ((const f32x4*)g)[2 * (64 * j + lane)]; gv[2 * j + 1] = ((const f32x4*)g)[2 * (64 * j + lane) + 1]; }
    for (int m = gw; m < T; m += NGW) {
        const u32x4* xr = (const u32x4*)(xb + (size_t)m * D) + lane;
        f32x4 v[8]; float s = 0.f;
#pragma unroll
        for (int j = 0; j < 4; ++j) { const u32x4 q = xr[64 * j];
            v[2 * j] = (f32x4){bflo(q.x), bfhi(q.x), bflo(q.y), bfhi(q.y)}; v[2 * j + 1] = (f32x4){bflo(q.z), bfhi(q.z), bflo(q.w), bfhi(q.w)}; }
#pragma unroll
        for (int j = 0; j < 8; ++j) s += (v[j].x * v[j].x + v[j].y * v[j].y) + (v[j].z * v[j].z + v[j].w * v[j].w);
        const float rstd = 1.0f / sqrtf(wave_sum(s) * (1.0f / D) + EPS);
        u32x4* o = (u32x4*)(xn + (size_t)m * D) + lane;
#pragma unroll
        for (int j = 0; j < 4; ++j) { const f32x4 a = v[2 * j] * rstd * gv[2 * j], b = v[2 * j + 1] * rstd * gv[2 * j + 1];
            u32x4 w; w.x = pk2(a.x, a.y); w.y = pk2(a.z, a.w); w.z = pk2(b.x, b.y); w.w = pk2(b.z, b.w); o[64 * j] = w; }
    }
}
__device__ __forceinline__ void final_norm_phase(const bf16* xb, const float* g, float* out, int gw, int NGW, int lane) {
    f32x4 gv[8];
#pragma unroll
    for (int j = 0; j < 4; ++j) { gv[2 * j] = ((const f32x4*)g)[2 * (64 * j + lane)]; gv[2 * j + 1] = ((const f32x4*)g)[2 * (64 * j + lane) + 1]; }
    for (int m = gw; m < T; m += NGW) {
        const u32x4* xr = (const u32x4*)(xb + (size_t)m * D) + lane;
        f32x4 v[8]; float s = 0.f;
#pragma unroll
        for (int j = 0; j < 4; ++j) { const u32x4 q = xr[64 * j];
            v[2 * j] = (f32x4){bflo(q.x), bfhi(q.x), bflo(q.y), bfhi(q.y)}; v[2 * j + 1] = (f32x4){bflo(q.z), bfhi(q.z), bflo(q.w), bfhi(q.w)}; }
#pragma unroll
        for (int j = 0; j < 8; ++j) s += (v[j].x * v[j].x + v[j].y * v[j].y) + (v[j].z * v[j].z + v[j].w * v[j].w);
        const float rstd = 1.0f / sqrtf(wave_sum(s) * (1.0f / D) + EPS);
        f32x4* o = (f32x4*)(out + (size_t)m * D) + 2 * lane;
#pragma unroll
        for (int j = 0; j < 4; ++j) { o[128 * j] = v[2 * j] * rstd * gv[2 * j]; o[128 * j + 1] = v[2 * j + 1] * rstd * gv[2 * j + 1]; }
    }
}

__device__ __forceinline__ void conv_phase(const bf16* proj, const float* cw  , bf16* Y, int gtid, int GT) {
    for (int id = gtid; id < (T / 16) * (DCONV / 8); id += GT) {
        const int cgp = id & 127, tb = id >> 7, c0 = cgp * 8, t0 = tb * 16;
        float w0[8], w1[8], w2[8], um2[8], um1[8];
#pragma unroll
        for (int j = 0; j < 8; ++j) { w0[j] = cw[c0 + j]; w1[j] = cw[DCONV + c0 + j]; w2[j] = cw[2 * DCONV + c0 + j]; um2[j] = 0.f; um1[j] = 0.f; }
        if (t0 > 0) {
            const u32x4 a2 = *(const u32x4*)(proj + (size_t)(t0 - 2) * NIN + C_XV + c0), b2 = *(const u32x4*)(proj + (size_t)(t0 - 2) * NIN + C_GC + c0);
            const u32x4 a1 = *(const u32x4*)(proj + (size_t)(t0 - 1) * NIN + C_XV + c0), b1 = *(const u32x4*)(proj + (size_t)(t0 - 1) * NIN + C_GC + c0);
#pragma unroll
            for (int j = 0; j < 4; ++j) { um2[2 * j] = bflo(a2[j]) * bflo(b2[j]); um2[2 * j + 1] = bfhi(a2[j]) * bfhi(b2[j]); um1[2 * j] = bflo(a1[j]) * bflo(b1[j]); um1[2 * j + 1] = bfhi(a1[j]) * bfhi(b1[j]); }
        }
#pragma unroll 8
        for (int i = 0; i < 16; ++i) {
            const size_t ro = (size_t)(t0 + i) * NIN + c0;
            const u32x4 xv = *(const u32x4*)(proj + ro + C_XV), gc = *(const u32x4*)(proj + ro + C_GC), gb = *(const u32x4*)(proj + ro + C_GB);
            float u0[8], y[8];
#pragma unroll
            for (int j = 0; j < 4; ++j) { u0[2 * j] = bflo(xv[j]) * bflo(gc[j]); u0[2 * j + 1] = bfhi(xv[j]) * bfhi(gc[j]); }
#pragma unroll
            for (int j = 0; j < 8; ++j) y[j] = w0[j] * um2[j] + w1[j] * um1[j] + w2[j] * u0[j];
            u32x4 o;
#pragma unroll
            for (int j = 0; j < 4; ++j) o[j] = pk2(y[2 * j] * bflo(gb[j]), y[2 * j + 1] * bfhi(gb[j]));
            *(u32x4*)(Y + (size_t)(t0 + i) * D + c0) = o;
#pragma unroll
            for (int j = 0; j < 8; ++j) { um2[j] = um1[j]; um1[j] = u0[j]; }
        }
    }
}

constexpr int BC_LD = 132;
constexpr int TR_LD = 72;
constexpr int QK_LD = 136;
__device__ __forceinline__ float logsig(float z) { return fminf(z, 0.f) - __logf(1.0f + __expf(-fabsf(z))); }

__device__ __forceinline__ void gla_zl_chunk(const bf16* XN, const bf16* WzlT  , LAS unsigned char* lds, int c, int tid_in) {
    int tid = tid_in; asm volatile("" : "+v"(tid));
    const int lane = tid & 63, wave = tid >> 6, fr = lane & 15, fq = lane >> 4;
    LAS float* zl_s = (LAS float*)lds;
    LAS float* part = (LAS float*)(lds + 48640);
    f32x4 acc[4];
#pragma unroll
    for (int mt = 0; mt < 4; ++mt) acc[mt] = (f32x4){0.f, 0.f, 0.f, 0.f};
    const bf16* ap = XN + (size_t)(c * CH + fr) * D + 256 * wave + fq * 8;
    const bf16* bp = WzlT + (size_t)fr * D + 256 * wave + fq * 8;
#pragma unroll
    for (int ks = 0; ks < 8; ++ks) {
        const bf16x8 b = *(const bf16x8*)(bp + ks * 32);
#pragma unroll
        for (int mt = 0; mt < 4; ++mt) { const bf16x8 a = *(const bf16x8*)(ap + (size_t)(16 * mt) * D + ks * 32);
            acc[mt] = __builtin_amdgcn_mfma_f32_16x16x32_bf16(a, b, acc[mt], 0, 0, 0); }
    }
#pragma unroll
    for (int mt = 0; mt < 4; ++mt)
#pragma unroll
        for (int r = 0; r < 4; ++r) part[(wave * 64 + 16 * mt + 4 * fq + r) * 16 + fr] = acc[mt][r];
    __syncthreads();
#pragma unroll
    for (int i = 0; i < 2; ++i) { const int o = tid + NTHR * i; float s = 0.f;
#pragma unroll
        for (int w = 0; w < 8; ++w) s += part[w * 1024 + o];
        zl_s[o] = s; }
    __syncthreads();
}

__device__ __forceinline__ void gla1_tile(const bf16* proj, const float* gw2  , const float* gbias  , bf16* U, float* BC, float* DEC,
                                          LAS unsigned char* lds, int c, int hd, int tid_in) {
    int tid = tid_in; asm volatile("" : "+v"(tid));
    LAS float* zl_s = (LAS float*)lds;
    LAS float* w2_s = (LAS float*)(lds + 4096);
    LAS float* gb_s = (LAS float*)(lds + 12288);
    LAS float* seg_s = (LAS float*)(lds + 12800);
    LAS float* bc_s = (LAS float*)(lds + 14848);
    LAS bf16* kT_s = (LAS bf16*)(lds + 48640);
    LAS bf16* vT_s = (LAS bf16*)(lds + 67072);
    const int lane = tid & 63, wave = tid >> 6, fr = lane & 15, fq = lane >> 4;
    const size_t row0 = (size_t)c * CH;
    { const int idx = tid * 4, r = idx >> 7, k = idx & 127; const f32x4 w = *(const f32x4*)(gw2 + r * DQK + hd * HK + k); *(LAS f32x4*)(w2_s + idx) = w; }
    if (tid < 128) gb_s[tid] = gbias[hd * HK + tid];
    const int ps0 = (tid & 31) * 2, pk0 = (tid >> 5) * 8;
    const u32x4 ka = *(const u32x4*)(proj + (row0 + ps0) * NIN + C_K + hd * HK + pk0), kb = *(const u32x4*)(proj + (row0 + ps0 + 1) * NIN + C_K + hd * HK + pk0);
    u32x4 vpa[2], vpb[2];
#pragma unroll
    for (int it = 0; it < 2; ++it) { const int item = tid + NTHR * it, s0 = (item & 31) * 2, v0 = (item >> 5) * 8;
        vpa[it] = *(const u32x4*)(proj + (row0 + s0) * NIN + C_V + hd * HV + v0); vpb[it] = *(const u32x4*)(proj + (row0 + s0 + 1) * NIN + C_V + hd * HV + v0); }
    __syncthreads();
    const int k = tid & 127, tq = tid >> 7;
    {
        float w[16], pre[16]; const float bias = gb_s[k];
#pragma unroll
        for (int r = 0; r < 16; ++r) w[r] = w2_s[r * 128 + k];
        float run = 0.f;
#pragma unroll
        for (int i = 0; i < 16; ++i) { const int t = 16 * tq + i; float z = bias;
#pragma unroll
            for (int r = 0; r < 16; ++r) z += zl_s[t * 16 + r] * w[r];
            run += logsig(z) * (1.0f / 16.0f); pre[i] = run; }
        seg_s[tq * 128 + k] = run;
        __syncthreads();
        float off = 0.f;
#pragma unroll
        for (int q = 0; q < 3; ++q) off += (q < tq) ? seg_s[q * 128 + k] : 0.f;
#pragma unroll
        for (int i = 0; i < 16; ++i) { const int t = 16 * tq + i; const float b = pre[i] + off; bc_s[t * BC_LD + k] = b; BC[(row0 + t) * DQK + hd * HK + k] = b; }
        if (tq == 3) DEC[(size_t)c * DQK + hd * HK + k] = __expf(pre[15] + off);
    }
    __syncthreads();
    { const int s0 = ps0, k0 = pk0;
#pragma unroll
        for (int j = 0; j < 8; ++j) { const float bl = bc_s[63 * BC_LD + k0 + j];
            const float fa = ((j & 1) ? bfhi(ka[j >> 1]) : bflo(ka[j >> 1])) * __expf(bl - bc_s[s0 * BC_LD + k0 + j]);
            const float fb = ((j & 1) ? bfhi(kb[j >> 1]) : bflo(kb[j >> 1])) * __expf(bl - bc_s[(s0 + 1) * BC_LD + k0 + j]);
            *(LAS unsigned*)(kT_s + (k0 + j) * TR_LD + s0) = pk2(fa, fb); } }
#pragma unroll
    for (int it = 0; it < 2; ++it) { const int item = tid + NTHR * it, s0 = (item & 31) * 2, v0 = (item >> 5) * 8;
        const u32x4 va = vpa[it], vb = vpb[it];
#pragma unroll
        for (int p = 0; p < 4; ++p) { *(LAS unsigned*)(vT_s + (v0 + 2 * p) * TR_LD + s0) = (va[p] & 0xffffu) | (vb[p] << 16);
            *(LAS unsigned*)(vT_s + (v0 + 2 * p + 1) * TR_LD + s0) = (va[p] >> 16) | (vb[p] & 0xffff0000u); } }
    __syncthreads();
    f32x4 acc[8][2];
#pragma unroll
    for (int mt = 0; mt < 8; ++mt) { acc[mt][0] = (f32x4){0.f, 0.f, 0.f, 0.f}; acc[mt][1] = (f32x4){0.f, 0.f, 0.f, 0.f}; }
#pragma unroll
    for (int ks = 0; ks < 2; ++ks) {
        bf16x8 vb[2];
#pragma unroll
        for (int nt = 0; nt < 2; ++nt) vb[nt] = *(const LAS bf16x8*)(vT_s + (32 * wave + 16 * nt + fr) * TR_LD + ks * 32 + fq * 8);
#pragma unroll
        for (int mt = 0; mt < 8; ++mt) { const bf16x8 ka = *(const LAS bf16x8*)(kT_s + (16 * mt + fr) * TR_LD + ks * 32 + fq * 8);
            acc[mt][0] = __builtin_amdgcn_mfma_f32_16x16x32_bf16(ka, vb[0], acc[mt][0], 0, 0, 0);
            acc[mt][1] = __builtin_amdgcn_mfma_f32_16x16x32_bf16(ka, vb[1], acc[mt][1], 0, 0, 0); }
    }
    bf16* Ut = U + (size_t)(c * NH + hd) * HV * HK;
#pragma unroll
    for (int mt = 0; mt < 8; ++mt)
#pragma unroll
        for (int nt = 0; nt < 2; ++nt) { u32x2 w; w.x = pk2(acc[mt][nt][0], acc[mt][nt][1]); w.y = pk2(acc[mt][nt][2], acc[mt][nt][3]);
            *(u32x2*)(Ut + (size_t)(32 * wave + 16 * nt + fr) * HK + 16 * mt + 4 * fq) = w; }
    __syncthreads();
}

constexpr int SCAN_B = 32;
__device__ __forceinline__ void scan_phase(bf16* U, bf16* So, const float* DEC, int bid, int G, int tid) {
    if (tid >= 256) return;
    for (int e = bid * 256 + tid; e < NH * HV * (HK / 2); e += G * 256) {
        const int hd = e >> 14, rem = e & 16383, v = rem >> 6, kp = rem & 63;
        unsigned* up = (unsigned*)(U + ((size_t)hd * HV + v) * HK + 2 * kp);
        unsigned* op = (unsigned*)(So + ((size_t)hd * HV + v) * HK + 2 * kp);
        const f32x2* dp = (const f32x2*)(DEC + hd * HK + 2 * kp);
        float s0 = 0.f, s1 = 0.f;
        for (int c0 = 0; c0 < NCH; c0 += SCAN_B) {
            unsigned ub[SCAN_B]; f32x2 db[SCAN_B];
#pragma unroll
            for (int i = 0; i < SCAN_B; ++i) { ub[i] = up[(size_t)(c0 + i) * (NH * HV * HK / 2)]; db[i] = dp[(size_t)(c0 + i) * (DQK / 2)]; }
#pragma unroll
            for (int i = 0; i < SCAN_B; ++i) { op[(size_t)(c0 + i) * (NH * HV * HK / 2)] = pk2(s0, s1); s0 = db[i].x * s0 + bflo(ub[i]); s1 = db[i].y * s1 + bfhi(ub[i]); }
        }
    }
}

__device__ __forceinline__ void gla3_tile(const bf16* proj, const bf16* Sg, const float* BC, const float* gn  , bf16* Y,
                                          LAS unsigned char* lds, int c, int hd, int tid_in) {
    int tid = tid_in; asm volatile("" : "+v"(tid));
    LAS bf16* QE_s = (LAS bf16*)lds;
    LAS bf16* QM_s = (LAS bf16*)(lds + 17408);
    LAS bf16* KD_s = (LAS bf16*)(lds + 34816);
    LAS bf16* KM_s = (LAS bf16*)(lds + 52224);
    LAS bf16* vT_s = (LAS bf16*)(lds + 69632);
    LAS bf16* P_s = (LAS bf16*)(lds + 106496);
    LAS float* red_s = (LAS float*)(lds + 115712);
    const int lane = tid & 63, wave = tid >> 6, fr = lane & 15, fq = lane >> 4;
    const size_t row0 = (size_t)c * CH;
    const float qscale = 0.08838834764831845f;
    const bf16* St = Sg + (size_t)(c * NH + hd) * HV * HK;
    bf16x8 sfr[4][2]; u32x2 gpre[4][2];
#pragma unroll
    for (int ks = 0; ks < 4; ++ks)
#pragma unroll
        for (int nt = 0; nt < 2; ++nt) sfr[ks][nt] = *(const bf16x8*)(St + (size_t)(32 * wave + 16 * nt + fr) * HK + ks * 32 + fq * 8);
#pragma unroll
    for (int mt = 0; mt < 4; ++mt)
#pragma unroll
        for (int nt = 0; nt < 2; ++nt) gpre[mt][nt] = *(const u32x2*)(proj + (row0 + 16 * mt + fr) * NIN + C_G + hd * HV + 32 * wave + 16 * nt + 4 * fq);
#pragma unroll
    for (int it = 0; it < 2; ++it) { const int ch = tid + NTHR * it, s = ch >> 4, k0 = (ch & 15) * 8;
        const u32x4 qv = *(const u32x4*)(proj + (row0 + s) * NIN + C_Q + hd * HK + k0), kv = *(const u32x4*)(proj + (row0 + s) * NIN + C_K + hd * HK + k0);
        const f32x4 b0 = *(const f32x4*)(BC + (row0 + s) * DQK + hd * HK + k0), b1 = *(const f32x4*)(BC + (row0 + s) * DQK + hd * HK + k0 + 4);
        u32x4 qe, qm, kd, km;
#pragma unroll
        for (int j = 0; j < 4; ++j) { const float ba = (j < 2) ? b0[2 * j] : b1[2 * j - 4], bb = (j < 2) ? b0[2 * j + 1] : b1[2 * j - 3];
            const float ea = __expf(ba), eb = __expf(bb), ia = __expf(-ba), ib = __expf(-bb);
            const float qa = bflo(qv[j]) * qscale, qb = bfhi(qv[j]) * qscale, ka = bflo(kv[j]), kb = bfhi(kv[j]);
            qe[j] = pk2(qa * ea, qb * eb); qm[j] = pk2(qa * ia, qb * ib); kd[j] = pk2(ka * ia, kb * ib); km[j] = pk2(ka * ea, kb * eb); }
        *(LAS u32x4*)(QE_s + s * QK_LD + k0) = qe; *(LAS u32x4*)(QM_s + s * QK_LD + k0) = qm; *(LAS u32x4*)(KD_s + s * QK_LD + k0) = kd; *(LAS u32x4*)(KM_s + s * QK_LD + k0) = km; }
#pragma unroll
    for (int it = 0; it < 2; ++it) { const int item = tid + NTHR * it, s0 = (item & 31) * 2, v0 = (item >> 5) * 8;
        const u32x4 va = *(const u32x4*)(proj + (row0 + s0) * NIN + C_V + hd * HV + v0), vb = *(const u32x4*)(proj + (row0 + s0 + 1) * NIN + C_V + hd * HV + v0);
#pragma unroll
        for (int p = 0; p < 4; ++p) { *(LAS unsigned*)(vT_s + (v0 + 2 * p) * TR_LD + s0) = (va[p] & 0xffffu) | (vb[p] << 16);
            *(LAS unsigned*)(vT_s + (v0 + 2 * p + 1) * TR_LD + s0) = (va[p] >> 16) | (vb[p] & 0xffff0000u); } }
    __syncthreads();
#pragma unroll
    for (int pi = 0; pi < 2; ++pi) { const int p = wave + 8 * pi, tt = p >> 2, st = p & 3;
        f32x4 lo = (f32x4){0.f, 0.f, 0.f, 0.f}, hi = (f32x4){0.f, 0.f, 0.f, 0.f};
        if (st <= tt) {
#pragma unroll
            for (int ks = 0; ks < 4; ++ks) { const bf16x8 a = *(const LAS bf16x8*)(KD_s + (16 * st + fr) * QK_LD + ks * 32 + fq * 8), b = *(const LAS bf16x8*)(QE_s + (16 * tt + fr) * QK_LD + ks * 32 + fq * 8);
                lo = __builtin_amdgcn_mfma_f32_16x16x32_bf16(a, b, lo, 0, 0, 0); } }
        if (st >= tt) {
#pragma unroll
            for (int ks = 0; ks < 4; ++ks) { const bf16x8 a = *(const LAS bf16x8*)(KM_s + (16 * st + fr) * QK_LD + ks * 32 + fq * 8), b = *(const LAS bf16x8*)(QM_s + (16 * tt + fr) * QK_LD + ks * 32 + fq * 8);
                hi = __builtin_amdgcn_mfma_f32_16x16x32_bf16(a, b, hi, 0, 0, 0); } }
        const int tabs = 16 * tt + fr, sabs = 16 * st + 4 * fq; float pv[4];
#pragma unroll
        for (int r = 0; r < 4; ++r) pv[r] = (sabs + r <= tabs) ? lo[r] : hi[r];
        u32x2 w; w.x = pk2(pv[0], pv[1]); w.y = pk2(pv[2], pv[3]);
        *(LAS u32x2*)(P_s + tabs * TR_LD + sabs) = w; }
    __syncthreads();
    f32x4 acc[4][2];
#pragma unroll
    for (int mt = 0; mt < 4; ++mt) { acc[mt][0] = (f32x4){0.f, 0.f, 0.f, 0.f}; acc[mt][1] = (f32x4){0.f, 0.f, 0.f, 0.f}; }
#pragma unroll
    for (int ks = 0; ks < 4; ++ks) {
        bf16x8 sa[2]; sa[0] = sfr[ks][0]; sa[1] = sfr[ks][1];
#pragma unroll
        for (int mt = 0; mt < 4; ++mt) { const bf16x8 qb = *(const LAS bf16x8*)(QE_s + (16 * mt + fr) * QK_LD + ks * 32 + fq * 8);
            acc[mt][0] = __builtin_amdgcn_mfma_f32_16x16x32_bf16(sa[0], qb, acc[mt][0], 0, 0, 0);
            acc[mt][1] = __builtin_amdgcn_mfma_f32_16x16x32_bf16(sa[1], qb, acc[mt][1], 0, 0, 0); }
    }
#pragma unroll
    for (int ks = 0; ks < 2; ++ks) {
        bf16x8 va[2];
#pragma unroll
        for (int nt = 0; nt < 2; ++nt) va[nt] = *(const LAS bf16x8*)(vT_s + (32 * wave + 16 * nt + fr) * TR_LD + ks * 32 + fq * 8);
#pragma unroll
        for (int mt = 0; mt < 4; ++mt) { const bf16x8 pb = *(const LAS bf16x8*)(P_s + (16 * mt + fr) * TR_LD + ks * 32 + fq * 8);
            acc[mt][0] = __builtin_amdgcn_mfma_f32_16x16x32_bf16(va[0], pb, acc[mt][0], 0, 0, 0);
            acc[mt][1] = __builtin_amdgcn_mfma_f32_16x16x32_bf16(va[1], pb, acc[mt][1], 0, 0, 0); }
    }
#pragma unroll
    for (int mt = 0; mt < 4; ++mt) { float ss = 0.f;
#pragma unroll
        for (int nt = 0; nt < 2; ++nt) { const f32x4 x = acc[mt][nt]; ss += (x[0] * x[0] + x[1] * x[1]) + (x[2] * x[2] + x[3] * x[3]); }
        ss += __shfl_xor(ss, 16); ss += __shfl_xor(ss, 32);
        if (fq == 0) red_s[wave * 64 + 16 * mt + fr] = ss; }
    __syncthreads();
#pragma unroll
    for (int mt = 0; mt < 4; ++mt) { const int t = 16 * mt + fr; float tot = 0.f;
#pragma unroll
        for (int w = 0; w < 8; ++w) tot += red_s[w * 64 + t];
        const float rstd = 1.0f / sqrtf(tot * (1.0f / HV) + EPS);
#pragma unroll
        for (int nt = 0; nt < 2; ++nt) { const int v = 32 * wave + 16 * nt + 4 * fq;
            const f32x4 gnv = *(const f32x4*)(gn + v);
            const u32x2 gg = gpre[mt][nt];
            const f32x4 x = acc[mt][nt];
            const float g0 = bflo(gg.x), g1 = bfhi(gg.x), g2 = bflo(gg.y), g3 = bfhi(gg.y);
            u32x2 w; w.x = pk2(x[0] * rstd * gnv[0] * pg8::silu_f(g0), x[1] * rstd * gnv[1] * pg8::silu_f(g1));
            w.y = pk2(x[2] * rstd * gnv[2] * pg8::silu_f(g2), x[3] * rstd * gnv[3] * pg8::silu_f(g3));
            *(u32x2*)(Y + (row0 + t) * D + DCONV + hd * HV + v) = w; } }
    __syncthreads();
}

#define XB_TMO      128
#define XB_XCNT(j)  (256  + 64 * (j))
#define XB_XSUB(j)  (1280 + 64 * (j))
#define XB_XGEN(j)  (2304 + 64 * (j))
#define XB_TOP      3328
#define XB_TOPGEN   3392
#define XCD_BAR_WORDS 3456
#define XB_SPIN_CAP (1u << 18)

__device__ __forceinline__ unsigned xb_ld(unsigned* p)              { return __hip_atomic_load(p, __ATOMIC_RELAXED, __HIP_MEMORY_SCOPE_AGENT); }
__device__ __forceinline__ unsigned xb_add(unsigned* p, unsigned v) { return __hip_atomic_fetch_add(p, v, __ATOMIC_RELAXED, __HIP_MEMORY_SCOPE_AGENT); }
__device__ __forceinline__ unsigned xb_xcc_id() { return (unsigned)__builtin_amdgcn_s_getreg((3 << 11) | 20) & 0xFu; }
#define XB_SPIN(cond, bar) do { unsigned _sp = 0; while (cond) { __builtin_amdgcn_s_sleep(1); \
    if ((++_sp & 255u) == 0u) { if (xb_ld(&(bar)[XB_TMO])) break; if (_sp > XB_SPIN_CAP) { atomicAdd(&(bar)[XB_TMO], 1u); break; } } } } while (0)

struct XcdBarrier {
    unsigned* bar; unsigned x;
    volatile LAS unsigned* st;
};

__device__ __forceinline__ XcdBarrier xcd_barrier_post(unsigned* bar, volatile LAS unsigned* st) {
    XcdBarrier b; b.bar = bar; b.x = xb_xcc_id(); b.st = st;
    if (threadIdx.x == 0) (void)xb_add(&bar[XB_XCNT(b.x)], 1u);
    return b;
}
__device__ __forceinline__ void xcd_barrier_complete(unsigned* bar, unsigned x, unsigned& nloc, unsigned& nx) {
    const unsigned G = gridDim.x * gridDim.y * gridDim.z;
    unsigned sum, cnt, mine, sp = 0u;
    for (;;) {
        sum = 0u; cnt = 0u; mine = 0u;
#pragma unroll
        for (unsigned j = 0; j < 16; ++j) { const unsigned c = xb_ld(&bar[XB_XCNT(j)]); sum += c; cnt += (c > 0u) ? 1u : 0u; mine = (j == x) ? c : mine; }
        if (sum == G) break;
        __builtin_amdgcn_s_sleep(1);
        if ((++sp & 255u) == 0u) { if (xb_ld(&bar[XB_TMO])) break; if (sp > XB_SPIN_CAP) { atomicAdd(&bar[XB_TMO], 1u); break; } }
    }
    nloc = mine > 0u ? mine : 1u; nx = cnt > 0u ? cnt : 1u;
}

__device__ __forceinline__ void xcd_barrier(const XcdBarrier& b) {
    asm volatile("s_waitcnt vmcnt(0)" ::: "memory");
    __syncthreads();
    if (threadIdx.x == 0) {
        unsigned* bar = b.bar;
        __builtin_amdgcn_s_waitcnt(0);
        unsigned nloc = b.st[0], nx = b.st[1];
        if (nloc == 0u) { xcd_barrier_complete(bar, b.x, nloc, nx); b.st[0] = nloc; b.st[1] = nx; }
        const unsigned old = xb_add(&bar[XB_XSUB(b.x)], 1u);
        const unsigned gen = old / nloc;
        if (old + 1u == (gen + 1u) * nloc) {
            __builtin_amdgcn_fence(__ATOMIC_RELEASE, "agent");
            asm volatile("s_waitcnt vmcnt(0)" ::: "memory");
            const unsigned og = xb_add(&bar[XB_TOP], 1u);
            const unsigned tg = og / nx;
            if (og + 1u == (tg + 1u) * nx) xb_add(&bar[XB_TOPGEN], 1u);
            else XB_SPIN(xb_ld(&bar[XB_TOPGEN]) == tg, bar);
            __builtin_amdgcn_fence(__ATOMIC_ACQUIRE, "agent");
            xb_add(&bar[XB_XGEN(b.x)], 1u);
            asm volatile("s_waitcnt vmcnt(0)" ::: "memory");
        } else {
            XB_SPIN(xb_ld(&bar[XB_XGEN(b.x)]) == gen, bar);
            __builtin_amdgcn_fence(__ATOMIC_ACQUIRE, "agent");
            asm volatile("s_waitcnt vmcnt(0)" ::: "memory");
        }
    }
    __syncthreads();
}

__global__ void __launch_bounds__(NTHR, 2) fwd_megakernel(Args a) {
    extern __shared__ __attribute__((aligned(16))) unsigned char lds_raw[];
    LAS unsigned char* lds = (LAS unsigned char*)lds_raw;
    cg::grid_group grid = cg::this_grid();
    const int G = gridDim.x, bid = blockIdx.x;
    const int vcu = (G % 8 == 0) ? (bid % 8) * (G / 8) + bid / 8 : bid;
    const int NGW = G * NWAVES, GT = G * NTHR;
    unsigned char* ws = a.ws;
    bf16* XN = (bf16*)(ws + WS_XN); bf16* Hb = (bf16*)(ws + WS_H); bf16* PROJ = (bf16*)(ws + WS_H); bf16* Yb = (bf16*)(ws + WS_Y); bf16* Ub = (bf16*)(ws + WS_U);
    float* BC = (float*)(ws + WS_BC); float* DEC = (float*)(ws + WS_DEC);
    bf16* XB = (bf16*)(ws + WS_XB);
    { volatile LAS unsigned* z = (volatile LAS unsigned*)(lds + 131072); if (threadIdx.x < 64) z[threadIdx.x] = 0u; }
    __syncthreads();
    const XcdBarrier xbar = xcd_barrier_post((unsigned*)(ws + WS_CTL), (volatile LAS unsigned*)(lds + 131072 + 64));
#define GRID_SYNC() xcd_barrier(xbar)
#define GRID_SYNC0() grid.sync()
#define PHASE_IDS int tid = threadIdx.x; asm volatile("" : "+v"(tid)); const int lane = tid & 63, wave = __builtin_amdgcn_readfirstlane(tid >> 6), gw = vcu * NWAVES + wave, gtid = bid * NTHR + tid; (void)lane; (void)wave; (void)gw; (void)gtid;

#pragma unroll 1
    for (int l = 0; l < 2; ++l) {
        if (l == 0) { PHASE_IDS cast_phase(a.in[0], XB, gw, NGW, lane); }
        { PHASE_IDS convert_phase(&a, l, lds, gw, NGW, wave, lane, gtid, GT); }
#pragma unroll 1
        for (int f = 0; f < 2; ++f) {
            if (l == 0 && f == 0) GRID_SYNC0(); { PHASE_IDS norm_phase(XB, (f == 0 ? a.in[1] : a.in[12]) + (size_t)l * D, XN, gw, NGW, lane); }
            GRID_SYNC();
            { pg8::Gemm g{XN, (const bf16*)(ws + (f == 0 ? WS_F1UP : WS_F2UP)), T, NUP, D}; pg8::StaticOrder S; S.init(T, NUP, G, bid);
              pg8::EpiSwiglu E{Hb, FF};
              _Pragma("unroll 1") for (int rep = 0; rep < REP_GEMM; ++rep)
              pg8::gemm_phase<pg8::EpiSwiglu, pg8::StaticOrder, true, true>(lds, g, S, E); }
            GRID_SYNC();
            { pg8::Gemm g{Hb, (const bf16*)(ws + (f == 0 ? WS_F1DN : WS_F2DN)), T, D, FF}; pg8::StaticOrder S; S.init(T, D, G, bid);
              pg8::EpiResid E{XB, D, 0.5f};
              pg8::gemm_phase<pg8::EpiResid, pg8::StaticOrder, true, true>(lds, g, S, E); }
            GRID_SYNC();
            if (f == 0) {
                { PHASE_IDS norm_phase(XB, a.in[5] + (size_t)l * D, XN, gw, NGW, lane); }
                GRID_SYNC();
                { pg8::Gemm g{XN, (const bf16*)(ws + WS_WIN), T, C_ZL, D}; pg8::StaticOrder S; S.init(T, C_ZL, G, bid);
                  pg8::EpiStoreBf16 E{PROJ, NIN};
                  _Pragma("unroll 1") for (int rep = 0; rep < REP_GEMM; ++rep)
                  pg8::gemm_phase<pg8::EpiStoreBf16, pg8::StaticOrder, true, true>(lds, g, S, E); }
                GRID_SYNC();
#pragma unroll 1
                for (int c = bid; c < NCH; c += G) { gla_zl_chunk(XN, (const bf16*)(ws + WS_WIN) + (size_t)C_ZL * D, lds, c, threadIdx.x);
#pragma unroll 1
                    for (int hd = 0; hd < NH; ++hd) gla1_tile(PROJ, a.in[8] + (size_t)l * RANK * DQK, a.in[9] + (size_t)l * DQK, Ub, BC, DEC, lds, c, hd, threadIdx.x); }
                GRID_SYNC();
                { PHASE_IDS if (tid < 256) scan_phase(Ub, Ub, DEC, bid, G, tid); else conv_phase(PROJ, a.in[7] + (size_t)l * 3 * DCONV, Yb, bid * 256 + (tid - 256), G * 256); }
                GRID_SYNC();
#pragma unroll 1
                for (int id = bid; id < REP_GLA * NCH * NH; id += G) gla3_tile(PROJ, Ub, BC, a.in[10] + (size_t)l * HV, Yb, lds, (id >> 2) & 255, id & 3, threadIdx.x);
                GRID_SYNC();
                { pg8::Gemm g{Yb, (const bf16*)(ws + WS_WOUT), T, D, D}; pg8::StaticOrder S; S.init(T, D, G, bid);
                  pg8::EpiResid E{XB, D, 1.0f};
                  pg8::gemm_phase<pg8::EpiResid, pg8::StaticOrder, true, true>(lds, g, S, E); }
                GRID_SYNC();
            }
        }
    }
    { PHASE_IDS final_norm_phase(XB, a.in[16], a.out, gw, NGW, lane); }
}

extern "C" void kernel_launch(void* const* d_in, const int* in_sizes, int n_in, void* d_out, int out_size, void* d_ws, size_t ws_size, hipStream_t stream) {
    static int grid = 0;
    if (grid == 0) {
        if (n_in != 17 || out_size != T * D || ws_size < WS_END) { fprintf(stderr, "kernel_launch: unexpected sizes n_in %d out %d ws %zu\n", n_in, out_size, ws_size); grid = -1; return; }
        int dev = 0, cus = 0, per_cu = 0;
        hipGetDevice(&dev); hipDeviceGetAttribute(&cus, hipDeviceAttributeMultiprocessorCount, dev);
        if (hipFuncSetAttribute((const void*)fwd_megakernel, hipFuncAttributeMaxDynamicSharedMemorySize, LDS_BYTES) != hipSuccess) { fprintf(stderr, "kernel_launch: hipFuncSetAttribute failed\n"); grid = -1; return; }
        if (hipOccupancyMaxActiveBlocksPerMultiprocessor(&per_cu, (const void*)fwd_megakernel, NTHR, LDS_BYTES) != hipSuccess || per_cu < 1) per_cu = 1;
        (void)hipGetLastError();
        grid = cus * per_cu;
    }
    if (grid < 0) return;
    Args a{};
    for (int i = 0; i < 17; ++i) a.in[i] = (const float*)d_in[i];
    a.out = (float*)d_out; a.ws = (unsigned char*)d_ws;
    if (hipMemsetAsync((char*)d_ws + WS_CTL, 0, CTL_BYTES, stream) != hipSuccess) { fprintf(stderr, "kernel_launch: memset failed\n"); return; }
    void* args[] = {&a};
    hipError_t e = hipLaunchCooperativeKernel((const void*)fwd_megakernel, dim3(grid), dim3(NTHR), args, LDS_BYTES, stream);
    if (e != hipSuccess) fprintf(stderr, "cooperative launch failed: %s (grid %d)\n", hipGetErrorString(e), grid);
}
```

```cpp
#include <hip/hip_runtime.h>
#include <hip/hip_cooperative_groups.h>
#include <cstdio>
#include <cstdint>
namespace pg8 {
#define PG8_LAS __attribute__((address_space(3)))
typedef unsigned short bf16_t;
typedef short bf16x8 __attribute__((ext_vector_type(8)));
typedef float f32x4 __attribute__((ext_vector_type(4)));
typedef unsigned u32x4 __attribute__((ext_vector_type(4)));
constexpr int BM = 256, BK = 64, HALF = 128, HTB = HALF * BK * 2  , STAGE_BYTES = 8 * HTB, NXCD = 8, WGM = 8;

__host__ __device__ __forceinline__ int lds_byte(int r, int c) { const int st = (r >> 4) * 2 + (c >> 5), rr = r & 15, cc = c & 31, ob = rr * 64 + cc * 2; return st * 1024 + (ob ^ (((ob >> 9) & 1) << 5)); }
__host__ __device__ __forceinline__ void stage_rc(int b, int& R, int& C) { const int st = b / 1024, sb = b % 1024, swz = sb ^ (((sb >> 9) & 1) << 5); R = (st >> 1) * 16 + swz / 64; C = (st & 1) * 32 + (swz % 64) / 2; }
__host__ __device__ __forceinline__ int perm32(int rho) { const int n = rho >> 4, i = rho & 15; return 8 * (i >> 2) + 4 * n + (i & 3); }

struct Unit { int pm, pn; };
struct Gemm { const bf16_t* A; const bf16_t* Bt; int M, N, K; };

struct StaticOrder {
    int nM, nN, nwg, G, c;
    __host__ __device__ void init(int M, int N, int G_, int c_) { nM = M / BM; nN = N / BM; nwg = nM * nN; G = G_; c = c_; }
    __host__ __device__ bool next(int i, Unit& u) const {
        const long L = (long)i * G + c; if (L >= nwg) return false;
        int wgid = (int)L; { const int q = nwg / NXCD, r = nwg % NXCD, xcd = wgid % NXCD, off = wgid / NXCD; wgid = (xcd < r ? xcd * (q + 1) : r * (q + 1) + (xcd - r) * q) + off; }
        const int nig = WGM * nN, gid = wgid / nig, fm = gid * WGM, gsz = (nM - fm) < WGM ? (nM - fm) : WGM;
        u.pm = fm + ((wgid % nig) % gsz); u.pn = (wgid % nig) / gsz; return true;
    }
    __device__ __forceinline__ void a_ready(const Unit&) const {}
    __device__ __forceinline__ void done(const Unit&) const {}
};
__device__ __forceinline__ unsigned cvt_pk_bf16(float lo, float hi) { unsigned r; asm volatile("v_cvt_pk_bf16_f32 %0, %1, %2" : "=v"(r) : "v"(lo), "v"(hi)); return r; }
typedef float f32x2 __attribute__((ext_vector_type(2)));
__device__ __forceinline__ float silu_f(float g) { return g * __builtin_amdgcn_rcpf(1.0f + __expf(-g)); }
struct EpiSwiglu {
    static constexpr bool PERM = true, AFTER_DRAIN = false;
    bf16_t* H; int ldh;
    __device__ __forceinline__ void prefetch(const Unit&, int, int, PG8_LAS unsigned char*) const {}
    __device__ __forceinline__ void operator()(const f32x4 (&acc)[2][2][4][2], const Unit& u, int wr, int wc, int fr, int fq, PG8_LAS unsigned char*) const {
        const int row0 = u.pm * BM + wr * 64 + fr, col0 = u.pn * HALF + wc * 32 + 8 * fq;
#pragma unroll
        for (int ai = 0; ai < 2; ++ai)
#pragma unroll
            for (int m = 0; m < 4; ++m) { bf16_t* rowp = H + (size_t)(row0 + ai * HALF + m * 16) * ldh + col0;
                const f32x4 g0 = acc[ai][0][m][0], g1 = acc[ai][0][m][1], u0 = acc[ai][1][m][0], u1 = acc[ai][1][m][1];
                u32x4 w;
                w.x = cvt_pk_bf16(silu_f(g0[0]) * u0[0], silu_f(g0[1]) * u0[1]); w.y = cvt_pk_bf16(silu_f(g0[2]) * u0[2], silu_f(g0[3]) * u0[3]);
                w.z = cvt_pk_bf16(silu_f(g1[0]) * u1[0], silu_f(g1[1]) * u1[1]); w.w = cvt_pk_bf16(silu_f(g1[2]) * u1[2], silu_f(g1[3]) * u1[3]);
                *(u32x4*)rowp = w; }
    }
};
struct EpiStoreBf16 {
    static constexpr bool PERM = true, AFTER_DRAIN = false;
    bf16_t* O; int ldc;
    __device__ __forceinline__ void prefetch(const Unit&, int, int, PG8_LAS unsigned char*) const {}
    __device__ __forceinline__ void operator()(const f32x4 (&acc)[2][2][4][2], const Unit& u, int wr, int wc, int fr, int fq, PG8_LAS unsigned char*) const {
        const int row0 = u.pm * BM + wr * 64 + fr, col0 = u.pn * BM + wc * 32 + 8 * fq;
#pragma unroll
        for (int ai = 0; ai < 2; ++ai)
#pragma unroll
            for (int m = 0; m < 4; ++m) { bf16_t* rowp = O + (size_t)(row0 + ai * HALF + m * 16) * ldc + col0;
#pragma unroll
                for (int bj = 0; bj < 2; ++bj) { const f32x4 v0 = acc[ai][bj][m][0], v1 = acc[ai][bj][m][1];
                    u32x4 w; w.x = cvt_pk_bf16(v0[0], v0[1]); w.y = cvt_pk_bf16(v0[2], v0[3]); w.z = cvt_pk_bf16(v1[0], v1[1]); w.w = cvt_pk_bf16(v1[2], v1[3]);
                    *(u32x4*)(rowp + bj * HALF) = w; } }
    }
};
struct EpiResid {
    static constexpr bool PERM = true, AFTER_DRAIN = false;
    bf16_t* xb; int ldc; float scale;
    __device__ __forceinline__ void prefetch(const Unit&, int, int, PG8_LAS unsigned char*) const {}
    __device__ __forceinline__ void operator()(const f32x4 (&acc)[2][2][4][2], const Unit& u, int wr, int wc, int fr, int fq, PG8_LAS unsigned char*) const {
        const int row0 = u.pm * BM + wr * 64 + fr, col0 = u.pn * BM + wc * 32 + 8 * fq;
#pragma unroll
        for (int ai = 0; ai < 2; ++ai)
#pragma unroll
        for (int mh = 0; mh < 2; ++mh) {
            u32x4 r[2][2];
#pragma unroll
            for (int m2 = 0; m2 < 2; ++m2) { const size_t off = (size_t)(row0 + ai * HALF + (2 * mh + m2) * 16) * ldc + col0;
#pragma unroll
                for (int bj = 0; bj < 2; ++bj) r[m2][bj] = *(const u32x4*)(xb + off + bj * HALF); }
#pragma unroll
            for (int m2 = 0; m2 < 2; ++m2) { const int m = 2 * mh + m2; const size_t off = (size_t)(row0 + ai * HALF + m * 16) * ldc + col0;
#pragma unroll
                for (int bj = 0; bj < 2; ++bj) {
                    const u32x4 q = r[m2][bj]; f32x4 o0, o1;
                    o0[0] = __uint_as_float(q.x << 16); o0[1] = __uint_as_float(q.x & 0xffff0000u); o0[2] = __uint_as_float(q.y << 16); o0[3] = __uint_as_float(q.y & 0xffff0000u);
                    o1[0] = __uint_as_float(q.z << 16); o1[1] = __uint_as_float(q.z & 0xffff0000u); o1[2] = __uint_as_float(q.w << 16); o1[3] = __uint_as_float(q.w & 0xffff0000u);
                    o0 = o0 + acc[ai][bj][m][0] * scale; o1 = o1 + acc[ai][bj][m][1] * scale;
                    u32x4 w; w.x = cvt_pk_bf16(o0[0], o0[1]); w.y = cvt_pk_bf16(o0[2], o0[3]); w.z = cvt_pk_bf16(o1[0], o1[1]); w.w = cvt_pk_bf16(o1[2], o1[3]);
                    *(u32x4*)(xb + off + bj * HALF) = w; } }
            asm volatile("" ::: "memory"); }
    }
};
template <class Epi, class Sched, bool ALIGN_EPI = false, bool SP2 = false>
__device__ __forceinline__ void gemm_phase(PG8_LAS unsigned char* lds, const Gemm g, const Sched& S, const Epi& E) {
    int tid_ = threadIdx.x; asm volatile("" : "+v"(tid_)); const int tid = tid_, wid = __builtin_amdgcn_readfirstlane(tid >> 6), lane = tid & 63, wr = wid >> 2, wc = wid & 3, fr = lane & 15, fq = lane >> 4;
    const int K = g.K, nt = K / BK;
    unsigned voffA[2], voffB[2];
#pragma unroll
    for (int i = 0; i < 2; ++i) { int R, C; stage_rc(tid * 16 + i * 8192, R, C); const int Rb = Epi::PERM ? ((R & ~31) + perm32(R & 31)) : R;
        voffA[i] = (unsigned)(R * K + C) * 2u; voffB[i] = (unsigned)(Rb * K + C) * 2u; }
    const size_t kstep = (size_t)(BK * 2);
    const size_t hstep = (size_t)HALF * K * 2;
    const size_t tstep = 2 * hstep;
    const unsigned ldsw = (unsigned)wid * 1024u;
    const int aoff = lds_byte(wr * 64 + fr, fq * 8), boff = lds_byte(wc * 32 + fr, fq * 8);
#define PG8_SA(b, h) (((b) * 2 + (h)) * HTB)
#define PG8_SB(b, h) ((4 + (b) * 2 + (h)) * HTB)
#define PG8_STAGE(bufoff, gbase, voff) do { _Pragma("unroll") for (int _i = 0; _i < 2; ++_i) \
        __builtin_amdgcn_global_load_lds((const unsigned*)((const char*)(gbase) + (voff)[_i]), (PG8_LAS unsigned*)(lds + (bufoff) + ldsw + _i * 8192), 16, 0, 0); } while (0)
#define PG8_LDA(dst, b, h) do { _Pragma("unroll") for (int m = 0; m < 4; ++m) _Pragma("unroll") for (int k = 0; k < 2; ++k) dst[m][k] = *(const PG8_LAS bf16x8*)(lds + PG8_SA(b, h) + aoff + m * 2048 + k * 1024); } while (0)
#define PG8_LDB(dst, b, h) do { _Pragma("unroll") for (int n = 0; n < 2; ++n) _Pragma("unroll") for (int k = 0; k < 2; ++k) dst[n][k] = *(const PG8_LAS bf16x8*)(lds + PG8_SB(b, h) + boff + n * 2048 + k * 1024); } while (0)
#define PG8_MMA(ai, bj, At, Bt) do { __builtin_amdgcn_s_setprio(1); _Pragma("unroll") for (int m = 0; m < 4; ++m) _Pragma("unroll") for (int n = 0; n < 2; ++n) _Pragma("unroll") for (int k = 0; k < 2; ++k) \
        acc[ai][bj][m][n] = __builtin_amdgcn_mfma_f32_16x16x32_bf16(Bt[n][k], At[m][k], acc[ai][bj][m][n], 0, 0, 0); __builtin_amdgcn_s_setprio(0); } while (0)
#define PG8_WAIT_V(n) asm volatile("s_waitcnt vmcnt(" #n ")" ::: "memory")
#define PG8_WAIT_L(n) asm volatile("s_waitcnt lgkmcnt(" #n ")" ::: "memory")
#define PG8_BAR __builtin_amdgcn_s_barrier()
#define PG8_SCHED __builtin_amdgcn_sched_barrier(0)
    Unit cur, nxt; int ui = 0;
    if (!S.next(0, cur)) return;
    f32x4 acc[2][2][4][2];
#pragma unroll
    for (int a = 0; a < 2; ++a)
#pragma unroll
        for (int b = 0; b < 2; ++b)
#pragma unroll
            for (int m = 0; m < 4; ++m)
#pragma unroll
                for (int n = 0; n < 2; ++n) acc[a][b][m][n] = (f32x4){0.f, 0.f, 0.f, 0.f};
    bf16x8 At[4][2], B0[2][2], B1[2][2];
    const char* cA = (const char*)g.A + (size_t)cur.pm * tstep; const char* cB = (const char*)g.Bt + (size_t)cur.pn * tstep;
    S.a_ready(cur);
    if constexpr (SP2) {
        PG8_STAGE(PG8_SB(0, 0), cB, voffB); PG8_STAGE(PG8_SB(0, 1), cB + hstep, voffB); PG8_STAGE(PG8_SA(0, 0), cA, voffA); PG8_STAGE(PG8_SA(0, 1), cA + hstep, voffA);
        if (wr == 1) PG8_BAR;
        PG8_WAIT_V(2); PG8_BAR;
        PG8_STAGE(PG8_SB(1, 0), cB + kstep, voffB); PG8_STAGE(PG8_SA(1, 0), cA + kstep, voffA); PG8_STAGE(PG8_SB(1, 1), cB + hstep + kstep, voffB);
        PG8_WAIT_V(6); PG8_BAR;
    } else {
        PG8_STAGE(PG8_SB(0, 0), cB, voffB); PG8_STAGE(PG8_SA(0, 0), cA, voffA); PG8_STAGE(PG8_SB(0, 1), cB + hstep, voffB); PG8_STAGE(PG8_SA(0, 1), cA + hstep, voffA);
        if (wr == 1) PG8_BAR;
        PG8_WAIT_V(4); PG8_BAR;
        PG8_STAGE(PG8_SB(1, 0), cB + kstep, voffB); PG8_STAGE(PG8_SA(1, 0), cA + kstep, voffA); PG8_STAGE(PG8_SB(1, 1), cB + hstep + kstep, voffB);
        PG8_WAIT_V(6); PG8_BAR;
    }
    for (;;) {
        const bool has_next = S.next(ui + 1, nxt);
        const char* nA = has_next ? (const char*)g.A + (size_t)nxt.pm * tstep : cA; const char* nB = has_next ? (const char*)g.Bt + (size_t)nxt.pn * tstep : cB;
        for (int t = 0; t < nt; t += 2) {
            const bool last = (t == nt - 2);
            const char* a1 = cA + (size_t)(t + 1) * kstep;
            const char* a2 = last ? nA : cA + (size_t)(t + 2) * kstep; const char* b2 = last ? nB : cB + (size_t)(t + 2) * kstep;
            const char* a3 = a2 + kstep; const char* b3 = b2 + kstep;
            if (last && has_next) S.a_ready(nxt);
            if (last) E.prefetch(cur, wid, lane, lds + STAGE_BYTES + 1024);
            if constexpr (SP2) {
            PG8_LDB(B0, 0, 0); PG8_LDB(B1, 0, 1); PG8_SCHED; PG8_LDA(At, 0, 0); PG8_STAGE(PG8_SA(1, 1), a1 + hstep, voffA);
            PG8_WAIT_V(8); PG8_WAIT_L(0); PG8_BAR; PG8_MMA(0, 0, At, B0); PG8_MMA(0, 1, At, B1); PG8_BAR; PG8_SCHED;
            PG8_LDA(At, 0, 1); PG8_STAGE(PG8_SB(0, 0), b2, voffB); PG8_STAGE(PG8_SB(0, 1), b2 + hstep, voffB); PG8_STAGE(PG8_SA(0, 0), a2, voffA);
            PG8_WAIT_V(8); PG8_WAIT_L(0); PG8_BAR; PG8_MMA(1, 0, At, B0); PG8_MMA(1, 1, At, B1); PG8_BAR; PG8_SCHED;
            PG8_LDB(B0, 1, 0); PG8_LDB(B1, 1, 1); PG8_SCHED; PG8_LDA(At, 1, 0); PG8_STAGE(PG8_SA(0, 1), a2 + hstep, voffA);
            PG8_WAIT_V(8); PG8_WAIT_L(0); PG8_BAR; PG8_MMA(0, 0, At, B0); PG8_MMA(0, 1, At, B1); PG8_BAR; PG8_SCHED;
            PG8_LDA(At, 1, 1); PG8_STAGE(PG8_SB(1, 0), b3, voffB); PG8_STAGE(PG8_SB(1, 1), b3 + hstep, voffB); PG8_STAGE(PG8_SA(1, 0), a3, voffA);
            PG8_WAIT_V(8); PG8_WAIT_L(0); PG8_BAR; PG8_MMA(1, 0, At, B0); PG8_MMA(1, 1, At, B1); PG8_BAR; PG8_SCHED;
            } else {
            PG8_LDB(B0, 0, 0); PG8_SCHED; PG8_LDA(At, 0, 0); PG8_STAGE(PG8_SA(1, 1), a1 + hstep, voffA);
            PG8_WAIT_L(8); PG8_BAR; PG8_WAIT_L(0); PG8_MMA(0, 0, At, B0); PG8_BAR; PG8_SCHED;
            PG8_LDB(B1, 0, 1); PG8_STAGE(PG8_SB(0, 0), b2, voffB);
            PG8_BAR; PG8_WAIT_L(0); PG8_MMA(0, 1, At, B1); PG8_BAR;
            PG8_LDA(At, 0, 1); PG8_STAGE(PG8_SA(0, 0), a2, voffA);
            PG8_BAR; PG8_WAIT_L(0); PG8_MMA(1, 0, At, B0); PG8_BAR; PG8_SCHED;
            PG8_STAGE(PG8_SB(0, 1), b2 + hstep, voffB);
            PG8_WAIT_V(6); PG8_BAR; PG8_MMA(1, 1, At, B1); PG8_BAR;
            PG8_LDB(B0, 1, 0); PG8_SCHED; PG8_LDA(At, 1, 0); PG8_STAGE(PG8_SA(0, 1), a2 + hstep, voffA);
            PG8_WAIT_L(8); PG8_BAR; PG8_WAIT_L(0); PG8_MMA(0, 0, At, B0); PG8_BAR; PG8_SCHED;
            PG8_LDB(B1, 1, 1); PG8_STAGE(PG8_SB(1, 0), b3, voffB);
            PG8_BAR; PG8_WAIT_L(0); PG8_MMA(0, 1, At, B1); PG8_BAR;
            PG8_LDA(At, 1, 1); PG8_STAGE(PG8_SA(1, 0), a3, voffA);
            PG8_BAR; PG8_WAIT_L(0); PG8_MMA(1, 0, At, B0); PG8_BAR; PG8_SCHED;
            PG8_STAGE(PG8_SB(1, 1), b3 + hstep, voffB);
            PG8_WAIT_V(6); PG8_BAR; PG8_MMA(1, 1, At, B1); PG8_BAR;
            }
        }
        if constexpr (ALIGN_EPI) { if (wr == 0) PG8_BAR; }
        if constexpr (!Epi::AFTER_DRAIN) { E(acc, cur, wr, wc, fr, fq, lds + STAGE_BYTES + 1024); S.done(cur); }
        if (!has_next) break;
#pragma unroll
        for (int a = 0; a < 2; ++a)
#pragma unroll
            for (int b = 0; b < 2; ++b)
#pragma unroll
                for (int m = 0; m < 4; ++m)
#pragma unroll
                    for (int n = 0; n < 2; ++n) acc[a][b][m][n] = (f32x4){0.f, 0.f, 0.f, 0.f};
        cur = nxt; cA = nA; cB = nB; ++ui;
        if constexpr (ALIGN_EPI) { if (wr == 1) PG8_BAR; }
    }
    PG8_WAIT_V(0);
    if constexpr (!ALIGN_EPI) { if (wr == 0) PG8_BAR; }
    PG8_BAR;
    if constexpr (Epi::AFTER_DRAIN) { E.fused(acc, cur, wr, wc, fr, fq, lds, wid, lane); S.done(cur); }
#undef PG8_SA
#undef PG8_SB
#undef PG8_STAGE
#undef PG8_LDA
#undef PG8_LDB
#undef PG8_MMA
#undef PG8_WAIT_V
#undef PG8_WAIT_L
#undef PG8_BAR
#undef PG8_SCHED
}
}

namespace cg = cooperative_groups;
#define LAS __attribute__((address_space(3)))
typedef unsigned short bf16;
typedef unsigned u32x4 __attribute__((ext_vector_type(4)));
typedef unsigned u32x2 __attribute__((ext_vector_type(2)));
typedef float f32x4 __attribute__((ext_vector_type(4)));
typedef float f32x2 __attribute__((ext_vector_type(2)));
typedef short bf16x8 __attribute__((ext_vector_type(8)));
constexpr int NWAVES = 8, NTHR = 512;
constexpr int T = 16384, D = 2048, FF = 5632, NUP = 2 * FF, NINV = 6160, NIN = 6400;
constexpr int DCONV = 1024, DQK = 512, DGLA = 1024, HK = 128, HV = 256, NH = 4, RANK = 16, CH = 64, NCH = T / CH;
constexpr int C_XV = 0, C_GB = 1024, C_GC = 2048, C_Q = 3072, C_K = 3584, C_V = 4096, C_G = 5120, C_ZL = 6144;
constexpr float EPS = 1e-6f;
constexpr size_t MiB = 1u << 20;
constexpr size_t WS_F1UP = 0, WS_F1DN = 44 * MiB, WS_F2UP = 66 * MiB, WS_F2DN = 110 * MiB, WS_WIN = 132 * MiB, WS_WOUT = 157 * MiB;
constexpr size_t WS_XN = 166 * MiB, WS_H = 230 * MiB  , WS_Y = 430 * MiB, WS_U = 494 * MiB, WS_BC = 558 * MiB, WS_DEC = 590 * MiB, WS_CTL = 590 * MiB + 512 * 1024, CTL_BYTES = 16384, WS_XB = 594 * MiB  , WS_DUMMY = 658 * MiB, WS_END = 722 * MiB;
#ifndef REP_GEMM
#define REP_GEMM 1
#endif
#ifndef REP_CN
#define REP_CN 1
#endif
#ifndef REP_SCAN
#define REP_SCAN 1
#endif
#ifndef REP_GLA
#define REP_GLA 1
#endif
constexpr int LDS_BYTES = 135168;

__device__ __forceinline__ float bflo(unsigned u) { return __uint_as_float(u << 16); }
__device__ __forceinline__ float bfhi(unsigned u) { return __uint_as_float(u & 0xffff0000u); }
__device__ __forceinline__ float bf2f(unsigned short b) { return __uint_as_float(((unsigned)b) << 16); }
__device__ __forceinline__ unsigned pk2(float lo, float hi) { return pg8::cvt_pk_bf16(lo, hi); }
__device__ __forceinline__ float wave_sum(float v) {
#pragma unroll
    for (int o = 1; o < 64; o <<= 1) v += __shfl_xor(v, o);
    return v;
}
#define LDS_WAIT() asm volatile("s_waitcnt lgkmcnt(0)" ::: "memory")

struct Args { const float* in[17]; float* out; unsigned char* ws; };
typedef const Args* ArgP;
struct CvItem { const float* W; int K, N; bf16* WT; int dst_row0, k0, n0; const float* gain; };
__device__ __forceinline__ CvItem cv_decode(ArgP ap, int l, int it) {
    constexpr int I_UP = (D / 64) * (FF / 32);
    constexpr int NB_IN = (NINV + 31) / 32;
    constexpr int I_IN = (D / 64) * NB_IN;
    unsigned char* ws = ap->ws; CvItem c; int r = it;
    if (r < 6 * I_UP) {
        const int which = r / I_UP; r -= which * I_UP;
        const int f = which / 3, w3 = which % 3;
        c.W = (f == 0 ? (w3 == 0 ? ap->in[2] : (w3 == 1 ? ap->in[3] : ap->in[4])) : (w3 == 0 ? ap->in[13] : (w3 == 1 ? ap->in[14] : ap->in[15]))) + (size_t)l * D * FF;
        if (w3 < 2) { const int nblk = FF / 32, kb = r / nblk, nb = r % nblk; c.n0 = nb * 32; c.k0 = kb * 64; c.K = D; c.N = FF;
            c.WT = (bf16*)(ws + (f == 0 ? WS_F1UP : WS_F2UP)); c.dst_row0 = (c.n0 >> 7) * 256 + (c.n0 & 127) + (w3 == 1 ? 128 : 0); c.gain = nullptr; }
        else { const int nblk = D / 32, kb = r / nblk, nb = r % nblk; c.n0 = nb * 32; c.k0 = kb * 64; c.K = FF; c.N = D;
            c.WT = (bf16*)(ws + (f == 0 ? WS_F1DN : WS_F2DN)); c.dst_row0 = c.n0; c.gain = nullptr; }
        return c;
    }
    r -= 6 * I_UP;
    if (r < I_IN) { const int kb = r / NB_IN, nb = r % NB_IN; c.n0 = nb * 32; c.k0 = kb * 64; c.K = D; c.N = NINV; c.W = ap->in[6] + (size_t)l * D * NINV; c.WT = (bf16*)(ws + WS_WIN); c.dst_row0 = c.n0; c.gain = nullptr; return c; }
    r -= I_IN;
    { const int nblk = D / 32, kb = r / nblk, nb = r % nblk; c.n0 = nb * 32; c.k0 = kb * 64; c.K = D; c.N = D; c.W = ap->in[11] + (size_t)l * D * D; c.WT = (bf16*)(ws + WS_WOUT); c.dst_row0 = c.n0; c.gain = nullptr; }
    return c;
}
__device__ __forceinline__ void cv_load(const CvItem& c, int lane, f32x4 (&v)[8]) {
    const int col4 = (lane & 7) * 4; const bool ok = (c.n0 + col4) < c.N;
    const float* p = c.W + (size_t)(c.k0 + (lane >> 3)) * c.N + c.n0 + col4;
#pragma unroll
    for (int i = 0; i < 8; ++i) v[i] = ok ? *(const f32x4*)(p + (size_t)(8 * i) * c.N) : (f32x4){0.f, 0.f, 0.f, 0.f};
}
__device__ __forceinline__ void cv_process(const CvItem& c, int lane, const f32x4 (&v)[8], LAS float* scr) {
    const int col4 = (lane & 7) * 4, r0 = lane >> 3, cc = lane & 7;
    f32x4 g0 = (f32x4){1.f, 1.f, 1.f, 1.f}, g1 = g0;
    if (c.gain) { g0 = *(const f32x4*)(c.gain + c.k0 + 8 * cc); g1 = *(const f32x4*)(c.gain + c.k0 + 8 * cc + 4); }
#pragma unroll
    for (int i = 0; i < 8; ++i) { LAS float* d = scr + (r0 + 8 * i) * 33 + col4; d[0] = v[i][0]; d[1] = v[i][1]; d[2] = v[i][2]; d[3] = v[i][3]; }
    LDS_WAIT(); asm volatile("" ::: "memory");
#pragma unroll
    for (int j = 0; j < 4; ++j) { const int n = (lane >> 3) + 8 * j; const LAS float* s = scr + (8 * cc) * 33 + n;
        u32x4 o; o.x = pk2(s[0 * 33] * g0[0], s[1 * 33] * g0[1]); o.y = pk2(s[2 * 33] * g0[2], s[3 * 33] * g0[3]); o.z = pk2(s[4 * 33] * g1[0], s[5 * 33] * g1[1]); o.w = pk2(s[6 * 33] * g1[2], s[7 * 33] * g1[3]);
        *(u32x4*)(c.WT + (size_t)(c.dst_row0 + n) * c.K + c.k0 + 8 * cc) = o; }
    LDS_WAIT(); asm volatile("" ::: "memory");
}

__device__ __forceinline__ void convert_phase(ArgP ap, int l, LAS unsigned char* lds, int gw, int NGW, int wave, int lane, int gtid, int GT) {
    LAS float* scr = (LAS float*)(lds + wave * 16384);
    constexpr int I_UP = (D / 64) * (FF / 32), NB_IN = (NINV + 31) / 32, I_IN = (D / 64) * NB_IN, I_OUT = (D / 64) * (D / 32);
    constexpr int NITEMS = 6 * I_UP + I_IN + I_OUT;
    unsigned char* ws = ap->ws;
    int it = gw;
    if (it < NITEMS) {
        CvItem cur = cv_decode(ap, l, it); f32x4 v[8]; cv_load(cur, lane, v);
        for (;;) {
            const int nit = it + NGW; const bool more = nit < NITEMS;
            CvItem nxt = cur; f32x4 vn[8];
            if (more) { nxt = cv_decode(ap, l, nit); cv_load(nxt, lane, vn); }
            cv_process(cur, lane, v, scr);
            if (!more) break;
            cur = nxt; it = nit;
#pragma unroll
            for (int i = 0; i < 8; ++i) v[i] = vn[i];
        }
    }
    { u32x4* p = (u32x4*)(ws + WS_WIN + (size_t)(NB_IN * 32) * D * 2); const int n16 = (NIN - NB_IN * 32) * D * 2 / 16;
      for (int i = gtid; i < n16; i += GT) p[i] = (u32x4){0u, 0u, 0u, 0u}; }
}

__device__ __forceinline__ void cast_phase(const float* x, bf16* xb, int gw, int NGW, int lane) {
    for (int m = gw; m < T; m += NGW) {
        const f32x4* xr = (const f32x4*)(x + (size_t)m * D) + lane; u32x2* o = (u32x2*)(xb + (size_t)m * D) + lane;
#pragma unroll
        for (int j = 0; j < 8; ++j) { const f32x4 v = xr[64 * j]; u32x2 w; w.x = pk2(v.x, v.y); w.y = pk2(v.z, v.w); o[64 * j] = w; }
    }
}
__device__ __forceinline__ void norm_phase(const bf16* xb, const float* g, bf16* xn, int gw, int NGW, int lane) {
    f32x4 gv[8];
#pragma unroll
    for (int j = 0; j < 4; ++j) { gv[2 * j] = ((const f32x4*)g)[2 * (64 * j + lane)]; gv[2 * j + 1] = ((const f32x4*)g)[2 * (64 * j + lane) + 1]; }
    for (int m = gw; m < T; m += NGW) {
        const u32x4* xr = (const u32x4*)(xb + (size_t)m * D) + lane;
        f32x4 v[8]; float s = 0.f;
#pragma unroll
        for (int j = 0; j < 4; ++j) { const u32x4 q = xr[64 * j];
            v[2 * j] = (f32x4){bflo(q.x), bfhi(q.x), bflo(q.y), bfhi(q.y)}; v[2 * j + 1] = (f32x4){bflo(q.z), bfhi(q.z), bflo(q.w), bfhi(q.w)}; }
#pragma unroll
        for (int j = 0; j < 8; ++j) s += (v[j].x * v[j].x + v[j].y * v[j].y) + (v[j].z * v[j].z + v[j].w * v[j].w);
        const float rstd = 1.0f / sqrtf(wave_sum(s) * (1.0f / D) + EPS);
        u32x4* o = (u32x4*)(xn + (size_t)m * D) + lane;
#pragma unroll
        for (int j = 0; j < 4; ++j) { const f32x4 a = v[2 * j] * rstd * gv[2 * j], b = v[2 * j + 1] * rstd * gv[2 * j + 1];
            u32x4 w; w.x = pk2(a.x, a.y); w.y = pk2(a.z, a.w); w.z = pk2(b.x, b.y); w.w = pk2(b.z, b.w); o[64 * j] = w; }
    }
}
__device__ __forceinline__ void final_norm_phase(const bf16* xb, const float* g, float* out, int gw, int NGW, int lane) {
    f32x4 gv[8];
#pragma unroll
    for (int j = 0; j < 4; ++j) { gv[2 * j] = ((const f32x4*)g)[2 * (64 * j + lane)]; gv[2 * j + 1] = ((const f32x4*)g)[2 * (64 * j + lane) + 1]; }
    for (int m = gw; m < T; m += NGW) {
        const u32x4* xr = (const u32x4*)(xb + (size_t)m * D) + lane;
        f32x4 v[8]; float s = 0.f;
#pragma unroll
        for (int j = 0; j < 4; ++j) { const u32x4 q = xr[64 * j];
            v[2 * j] = (f32x4){bflo(q.x), bfhi(q.x), bflo(q.y), bfhi(q.y)}; v[2 * j + 1] = (f32x4){bflo(q.z), bfhi(q.z), bflo(q.w), bfhi(q.w)}; }
#pragma unroll
        for (int j = 0; j < 8; ++j) s += (v[j].x * v[j].x + v[j].y * v[j].y) + (v[j].z * v[j].z + v[j].w * v[j].w);
        const float rstd = 1.0f / sqrtf(wave_sum(s) * (1.0f / D) + EPS);
        f32x4* o = (f32x4*)(out + (size_t)m * D) + 2 * lane;
#pragma unroll
        for (int j = 0; j < 4; ++j) { o[128 * j] = v[2 * j] * rstd * gv[2 * j]; o[128 * j + 1] = v[2 * j + 1] * rstd * gv[2 * j + 1]; }
    }
}

__device__ __forceinline__ void conv_phase(const bf16* proj, const float* cw  , bf16* Y, int gtid, int GT) {
    for (int id = gtid; id < (T / 16) * (DCONV / 8); id += GT) {
        const int cgp = id & 127, tb = id >> 7, c0 = cgp * 8, t0 = tb * 16;
        float w0[8], w1[8], w2[8], um2[8], um1[8];
#pragma unroll
        for (int j = 0; j < 8; ++j) { w0[j] = cw[c0 + j]; w1[j] = cw[DCONV + c0 + j]; w2[j] = cw[2 * DCONV + c0 + j]; um2[j] = 0.f; um1[j] = 0.f; }
        if (t0 > 0) {
            const u32x4 a2 = *(const u32x4*)(proj + (size_t)(t0 - 2) * NIN + C_XV + c0), b2 = *(const u32x4*)(proj + (size_t)(t0 - 2) * NIN + C_GC + c0);
            const u32x4 a1 = *(const u32x4*)(proj + (size_t)(t0 - 1) * NIN + C_XV + c0), b1 = *(const u32x4*)(proj + (size_t)(t0 - 1) * NIN + C_GC + c0);
#pragma unroll
            for (int j = 0; j < 4; ++j) { um2[2 * j] = bflo(a2[j]) * bflo(b2[j]); um2[2 * j + 1] = bfhi(a2[j]) * bfhi(b2[j]); um1[2 * j] = bflo(a1[j]) * bflo(b1[j]); um1[2 * j + 1] = bfhi(a1[j]) * bfhi(b1[j]); }
        }
#pragma unroll 8
        for (int i = 0; i < 16; ++i) {
            const size_t ro = (size_t)(t0 + i) * NIN + c0;
            const u32x4 xv = *(const u32x4*)(proj + ro + C_XV), gc = *(const u32x4*)(proj + ro + C_GC), gb = *(const u32x4*)(proj + ro + C_GB);
            float u0[8], y[8];
#pragma unroll
            for (int j = 0; j < 4; ++j) { u0[2 * j] = bflo(xv[j]) * bflo(gc[j]); u0[2 * j + 1] = bfhi(xv[j]) * bfhi(gc[j]); }
#pragma unroll
            for (int j = 0; j < 8; ++j) y[j] = w0[j] * um2[j] + w1[j] * um1[j] + w2[j] * u0[j];
            u32x4 o;
#pragma unroll
            for (int j = 0; j < 4; ++j) o[j] = pk2(y[2 * j] * bflo(gb[j]), y[2 * j + 1] * bfhi(gb[j]));
            *(u32x4*)(Y + (size_t)(t0 + i) * D + c0) = o;
#pragma unroll
            for (int j = 0; j < 8; ++j) { um2[j] = um1[j]; um1[j] = u0[j]; }
        }
    }
}

constexpr int BC_LD = 132;
constexpr int TR_LD = 72;
constexpr int QK_LD = 136;
__device__ __forceinline__ float logsig(float z) { return fminf(z, 0.f) - __logf(1.0f + __expf(-fabsf(z))); }

__device__ __forceinline__ void gla_zl_chunk(const bf16* XN, const bf16* WzlT  , LAS unsigned char* lds, int c, int tid_in) {
    int tid = tid_in; asm volatile("" : "+v"(tid));
    const int lane = tid & 63, wave = tid >> 6, fr = lane & 15, fq = lane >> 4;
    LAS float* zl_s = (LAS float*)lds;
    LAS float* part = (LAS float*)(lds + 48640);
    f32x4 acc[4];
#pragma unroll
    for (int mt = 0; mt < 4; ++mt) acc[mt] = (f32x4){0.f, 0.f, 0.f, 0.f};
    const bf16* ap = XN + (size_t)(c * CH + fr) * D + 256 * wave + fq * 8;
    const bf16* bp = WzlT + (size_t)fr * D + 256 * wave + fq * 8;
#pragma unroll
    for (int ks = 0; ks < 8; ++ks) {
        const bf16x8 b = *(const bf16x8*)(bp + ks * 32);
#pragma unroll
        for (int mt = 0; mt < 4; ++mt) { const bf16x8 a = *(const bf16x8*)(ap + (size_t)(16 * mt) * D + ks * 32);
            acc[mt] = __builtin_amdgcn_mfma_f32_16x16x32_bf16(a, b, acc[mt], 0, 0, 0); }
    }
#pragma unroll
    for (int mt = 0; mt < 4; ++mt)
#pragma unroll
        for (int r = 0; r < 4; ++r) part[(wave * 64 + 16 * mt + 4 * fq + r) * 16 + fr] = acc[mt][r];
    __syncthreads();
#pragma unroll
    for (int i = 0; i < 2; ++i) { const int o = tid + NTHR * i; float s = 0.f;
#pragma unroll
        for (int w = 0; w < 8; ++w) s += part[w * 1024 + o];
        zl_s[o] = s; }
    __syncthreads();
}

struct G1In { f32x4 w2; float gb; u32x4 ka, kb, vpa[2], vpb[2]; };
__device__ __forceinline__ G1In gla1_load(const bf16* proj, const float* gw2, const float* gbias, size_t row0, int hd, int tid) {
    G1In in;
    { const int idx = tid * 4, r = idx >> 7, k = idx & 127; in.w2 = *(const f32x4*)(gw2 + r * DQK + hd * HK + k); }
    in.gb = gbias[hd * HK + (tid & 127)];
    const int ps0 = (tid & 31) * 2, pk0 = (tid >> 5) * 8;
    in.ka = *(const u32x4*)(proj + (row0 + ps0) * NIN + C_K + hd * HK + pk0); in.kb = *(const u32x4*)(proj + (row0 + ps0 + 1) * NIN + C_K + hd * HK + pk0);
#pragma unroll
    for (int it = 0; it < 2; ++it) { const int item = tid + NTHR * it, s0 = (item & 31) * 2, v0 = (item >> 5) * 8;
        in.vpa[it] = *(const u32x4*)(proj + (row0 + s0) * NIN + C_V + hd * HV + v0); in.vpb[it] = *(const u32x4*)(proj + (row0 + s0 + 1) * NIN + C_V + hd * HV + v0); }
    return in;
}
__device__ __forceinline__ void gla1_chunk(const bf16* proj, const float* gw2  , const float* gbias  , bf16* U, float* BC, float* DEC,
                                           LAS unsigned char* lds, int c, int tid_in) {
    int tid = tid_in; asm volatile("" : "+v"(tid));
    LAS float* zl_s = (LAS float*)lds;
    LAS float* w2_s = (LAS float*)(lds + 4096);
    LAS float* gb_s = (LAS float*)(lds + 12288);
    LAS float* seg_s = (LAS float*)(lds + 12800);
    LAS float* bc_s = (LAS float*)(lds + 14848);
    LAS bf16* kT_s = (LAS bf16*)(lds + 48640);
    LAS bf16* vT_s = (LAS bf16*)(lds + 67072);
    const int lane = tid & 63, wave = tid >> 6, fr = lane & 15, fq = lane >> 4;
    const size_t row0 = (size_t)c * CH;
    G1In in = gla1_load(proj, gw2, gbias, row0, 0, tid);
#pragma unroll 1
    for (int hd = 0; hd < NH; ++hd) {
        *(LAS f32x4*)(w2_s + tid * 4) = in.w2;
        if (tid < 128) gb_s[tid] = in.gb;
        __syncthreads();
        const int k = tid & 127, tq = tid >> 7;
        {
            float w[16], pre[16]; const float bias = gb_s[k];
#pragma unroll
            for (int r = 0; r < 16; ++r) w[r] = w2_s[r * 128 + k];
            float run = 0.f;
#pragma unroll
            for (int i = 0; i < 16; ++i) { const int t = 16 * tq + i; float z = bias;
                const f32x4 z0 = *(const LAS f32x4*)(zl_s + t * 16), z1 = *(const LAS f32x4*)(zl_s + t * 16 + 4), z2 = *(const LAS f32x4*)(zl_s + t * 16 + 8), z3 = *(const LAS f32x4*)(zl_s + t * 16 + 12);
#pragma unroll
                for (int r = 0; r < 4; ++r) { z += z0[r] * w[r]; }
#pragma unroll
                for (int r = 0; r < 4; ++r) { z += z1[r] * w[4 + r]; }
#pragma unroll
                for (int r = 0; r < 4; ++r) { z += z2[r] * w[8 + r]; }
#pragma unroll
                for (int r = 0; r < 4; ++r) { z += z3[r] * w[12 + r]; }
                run += logsig(z) * (1.0f / 16.0f); pre[i] = run; }
            seg_s[tq * 128 + k] = run;
            __syncthreads();
            float off = 0.f;
#pragma unroll
            for (int q = 0; q < 3; ++q) off += (q < tq) ? seg_s[q * 128 + k] : 0.f;
#pragma unroll
            for (int i = 0; i < 16; ++i) { const int t = 16 * tq + i; const float b = pre[i] + off; bc_s[t * BC_LD + k] = b; BC[(row0 + t) * DQK + hd * HK + k] = b; }
            if (tq == 3) DEC[(size_t)c * DQK + hd * HK + k] = __expf(pre[15] + off);
        }
        __syncthreads();
        { const int s0 = (tid & 31) * 2, k0 = (tid >> 5) * 8;
#pragma unroll
            for (int j = 0; j < 8; ++j) { const float bl = bc_s[63 * BC_LD + k0 + j];
                const float fa = ((j & 1) ? bfhi(in.ka[j >> 1]) : bflo(in.ka[j >> 1])) * __expf(bl - bc_s[s0 * BC_LD + k0 + j]);
                const float fb = ((j & 1) ? bfhi(in.kb[j >> 1]) : bflo(in.kb[j >> 1])) * __expf(bl - bc_s[(s0 + 1) * BC_LD + k0 + j]);
                *(LAS unsigned*)(kT_s + (k0 + j) * TR_LD + s0) = pk2(fa, fb); } }
#pragma unroll
        for (int it = 0; it < 2; ++it) { const int item = tid + NTHR * it, s0 = (item & 31) * 2, v0 = (item >> 5) * 8;
            const u32x4 va = in.vpa[it], vb = in.vpb[it];
#pragma unroll
            for (int p = 0; p < 4; ++p) { *(LAS unsigned*)(vT_s + (v0 + 2 * p) * TR_LD + s0) = (va[p] & 0xffffu) | (vb[p] << 16);
                *(LAS unsigned*)(vT_s + (v0 + 2 * p + 1) * TR_LD + s0) = (va[p] >> 16) | (vb[p] & 0xffff0000u); } }
        __syncthreads();
        f32x4 acc[8][2];
#pragma unroll
        for (int mt = 0; mt < 8; ++mt) { acc[mt][0] = (f32x4){0.f, 0.f, 0.f, 0.f}; acc[mt][1] = (f32x4){0.f, 0.f, 0.f, 0.f}; }
#pragma unroll
        for (int ks = 0; ks < 2; ++ks) {
            bf16x8 vb[2];
#pragma unroll
            for (int nt = 0; nt < 2; ++nt) vb[nt] = *(const LAS bf16x8*)(vT_s + (32 * wave + 16 * nt + fr) * TR_LD + ks * 32 + fq * 8);
#pragma unroll
            for (int mt = 0; mt < 8; ++mt) { const bf16x8 ka = *(const LAS bf16x8*)(kT_s + (16 * mt + fr) * TR_LD + ks * 32 + fq * 8);
                acc[mt][0] = __builtin_amdgcn_mfma_f32_16x16x32_bf16(ka, vb[0], acc[mt][0], 0, 0, 0);
                acc[mt][1] = __builtin_amdgcn_mfma_f32_16x16x32_bf16(ka, vb[1], acc[mt][1], 0, 0, 0); }
        }
        if (hd + 1 < NH) in = gla1_load(proj, gw2, gbias, row0, hd + 1, tid);
        bf16* Ut = U + (size_t)(c * NH + hd) * HV * HK;
#pragma unroll
        for (int mt = 0; mt < 8; ++mt)
#pragma unroll
            for (int nt = 0; nt < 2; ++nt) { u32x2 w; w.x = pk2(acc[mt][nt][0], acc[mt][nt][1]); w.y = pk2(acc[mt][nt][2], acc[mt][nt][3]);
                *(u32x2*)(Ut + (size_t)(32 * wave + 16 * nt + fr) * HK + 16 * mt + 4 * fq) = w; }
        __syncthreads();
    }
}

constexpr int SCAN_B = 32;
__device__ __forceinline__ void scan_phase(bf16* U, bf16* So, const float* DEC, int bid, int G, int tid) {
    if (tid >= 256) return;
    for (int e = bid * 256 + tid; e < NH * HV * (HK / 2); e += G * 256) {
        const int hd = e >> 14, rem = e & 16383, v = rem >> 6, kp = rem & 63;
        unsigned* up = (unsigned*)(U + ((size_t)hd * HV + v) * HK + 2 * kp);
        unsigned* op = (unsigned*)(So + ((size_t)hd * HV + v) * HK + 2 * kp);
        const f32x2* dp = (const f32x2*)(DEC + hd * HK + 2 * kp);
        float s0 = 0.f, s1 = 0.f;
        for (int c0 = 0; c0 < NCH; c0 += SCAN_B) {
            unsigned ub[SCAN_B]; f32x2 db[SCAN_B];
#pragma unroll
            for (int i = 0; i < SCAN_B; ++i) { ub[i] = up[(size_t)(c0 + i) * (NH * HV * HK / 2)]; db[i] = dp[(size_t)(c0 + i) * (DQK / 2)]; }
#pragma unroll
            for (int i = 0; i < SCAN_B; ++i) { op[(size_t)(c0 + i) * (NH * HV * HK / 2)] = pk2(s0, s1); s0 = db[i].x * s0 + bflo(ub[i]); s1 = db[i].y * s1 + bfhi(ub[i]); }
        }
    }
}

__device__ __forceinline__ void gla3_tile(const bf16* proj, const bf16* Sg, const float* BC, const float* gn  , bf16* Y,
                                          LAS unsigned char* lds, int c, int hd, int tid_in) {
    int tid = tid_in; asm volatile("" : "+v"(tid));
    LAS bf16* QE_s = (LAS bf16*)lds;
    LAS bf16* QM_s = (LAS bf16*)(lds + 17408);
    LAS bf16* KD_s = (LAS bf16*)(lds + 34816);
    LAS bf16* KM_s = (LAS bf16*)(lds + 52224);
    LAS bf16* vT_s = (LAS bf16*)(lds + 69632);
    LAS bf16* P_s = (LAS bf16*)(lds + 106496);
    LAS float* red_s = (LAS float*)(lds + 115712);
    const int lane = tid & 63, wave = tid >> 6, fr = lane & 15, fq = lane >> 4;
    const size_t row0 = (size_t)c * CH;
    const float qscale = 0.08838834764831845f;
    const bf16* St = Sg + (size_t)(c * NH + hd) * HV * HK;
    bf16x8 sfr[4][2]; u32x2 gpre[4][2];
#pragma unroll
    for (int ks = 0; ks < 4; ++ks)
#pragma unroll
        for (int nt = 0; nt < 2; ++nt) sfr[ks][nt] = *(const bf16x8*)(St + (size_t)(32 * wave + 16 * nt + fr) * HK + ks * 32 + fq * 8);
#pragma unroll
    for (int mt = 0; mt < 4; ++mt)
#pragma unroll
        for (int nt = 0; nt < 2; ++nt) gpre[mt][nt] = *(const u32x2*)(proj + (row0 + 16 * mt + fr) * NIN + C_G + hd * HV + 32 * wave + 16 * nt + 4 * fq);
#pragma unroll
    for (int it = 0; it < 2; ++it) { const int ch = tid + NTHR * it, s = ch >> 4, k0 = (ch & 15) * 8;
        const u32x4 qv = *(const u32x4*)(proj + (row0 + s) * NIN + C_Q + hd * HK + k0), kv = *(const u32x4*)(proj + (row0 + s) * NIN + C_K + hd * HK + k0);
        const f32x4 b0 = *(const f32x4*)(BC + (row0 + s) * DQK + hd * HK + k0), b1 = *(const f32x4*)(BC + (row0 + s) * DQK + hd * HK + k0 + 4);
        u32x4 qe, qm, kd, km;
#pragma unroll
        for (int j = 0; j < 4; ++j) { const float ba = (j < 2) ? b0[2 * j] : b1[2 * j - 4], bb = (j < 2) ? b0[2 * j + 1] : b1[2 * j - 3];
            const float ea = __expf(ba), eb = __expf(bb), ia = __expf(-ba), ib = __expf(-bb);
            const float qa = bflo(qv[j]) * qscale, qb = bfhi(qv[j]) * qscale, ka = bflo(kv[j]), kb = bfhi(kv[j]);
            qe[j] = pk2(qa * ea, qb * eb); qm[j] = pk2(qa * ia, qb * ib); kd[j] = pk2(ka * ia, kb * ib); km[j] = pk2(ka * ea, kb * eb); }
        *(LAS u32x4*)(QE_s + s * QK_LD + k0) = qe; *(LAS u32x4*)(QM_s + s * QK_LD + k0) = qm; *(LAS u32x4*)(KD_s + s * QK_LD + k0) = kd; *(LAS u32x4*)(KM_s + s * QK_LD + k0) = km; }
#pragma unroll
    for (int it = 0; it < 2; ++it) { const int item = tid + NTHR * it, s0 = (item & 31) * 2, v0 = (item >> 5) * 8;
        const u32x4 va = *(const u32x4*)(proj + (row0 + s0) * NIN + C_V + hd * HV + v0), vb = *(const u32x4*)(proj + (row0 + s0 + 1) * NIN + C_V + hd * HV + v0);
#pragma unroll
        for (int p = 0; p < 4; ++p) { *(LAS unsigned*)(vT_s + (v0 + 2 * p) * TR_LD + s0) = (va[p] & 0xffffu) | (vb[p] << 16);
            *(LAS unsigned*)(vT_s + (v0 + 2 * p + 1) * TR_LD + s0) = (va[p] >> 16) | (vb[p] & 0xffff0000u); } }
    __syncthreads();
#pragma unroll
    for (int pi = 0; pi < 2; ++pi) { const int p = wave + 8 * pi, tt = p >> 2, st = p & 3;
        f32x4 lo = (f32x4){0.f, 0.f, 0.f, 0.f}, hi = (f32x4){0.f, 0.f, 0.f, 0.f};
        if (st <= tt) {
#pragma unroll
            for (int ks = 0; ks < 4; ++ks) { const bf16x8 a = *(const LAS bf16x8*)(KD_s + (16 * st + fr) * QK_LD + ks * 32 + fq * 8), b = *(const LAS bf16x8*)(QE_s + (16 * tt + fr) * QK_LD + ks * 32 + fq * 8);
                lo = __builtin_amdgcn_mfma_f32_16x16x32_bf16(a, b, lo, 0, 0, 0); } }
        if (st >= tt) {
#pragma unroll
            for (int ks = 0; ks < 4; ++ks) { const bf16x8 a = *(const LAS bf16x8*)(KM_s + (16 * st + fr) * QK_LD + ks * 32 + fq * 8), b = *(const LAS bf16x8*)(QM_s + (16 * tt + fr) * QK_LD + ks * 32 + fq * 8);
                hi = __builtin_amdgcn_mfma_f32_16x16x32_bf16(a, b, hi, 0, 0, 0); } }
        const int tabs = 16 * tt + fr, sabs = 16 * st + 4 * fq; float pv[4];
#pragma unroll
        for (int r = 0; r < 4; ++r) pv[r] = (sabs + r <= tabs) ? lo[r] : hi[r];
        u32x2 w; w.x = pk2(pv[0], pv[1]); w.y = pk2(pv[2], pv[3]);
        *(LAS u32x2*)(P_s + tabs * TR_LD + sabs) = w; }
    __syncthreads();
    f32x4 acc[4][2];
#pragma unroll
    for (int mt = 0; mt < 4; ++mt) { acc[mt][0] = (f32x4){0.f, 0.f, 0.f, 0.f}; acc[mt][1] = (f32x4){0.f, 0.f, 0.f, 0.f}; }
#pragma unroll
    for (int ks = 0; ks < 4; ++ks) {
        bf16x8 sa[2]; sa[0] = sfr[ks][0]; sa[1] = sfr[ks][1];
#pragma unroll
        for (int mt = 0; mt < 4; ++mt) { const bf16x8 qb = *(const LAS bf16x8*)(QE_s + (16 * mt + fr) * QK_LD + ks * 32 + fq * 8);
            acc[mt][0] = __builtin_amdgcn_mfma_f32_16x16x32_bf16(sa[0], qb, acc[mt][0], 0, 0, 0);
            acc[mt][1] = __builtin_amdgcn_mfma_f32_16x16x32_bf16(sa[1], qb, acc[mt][1], 0, 0, 0); }
    }
#pragma unroll
    for (int ks = 0; ks < 2; ++ks) {
        bf16x8 va[2];
#pragma unroll
        for (int nt = 0; nt < 2; ++nt) va[nt] = *(const LAS bf16x8*)(vT_s + (32 * wave + 16 * nt + fr) * TR_LD + ks * 32 + fq * 8);
#pragma unroll
        for (int mt = 0; mt < 4; ++mt) { const bf16x8 pb = *(const LAS bf16x8*)(P_s + (16 * mt + fr) * TR_LD + ks * 32 + fq * 8);
            acc[mt][0] = __builtin_amdgcn_mfma_f32_16x16x32_bf16(va[0], pb, acc[mt][0], 0, 0, 0);
            acc[mt][1] = __builtin_amdgcn_mfma_f32_16x16x32_bf16(va[1], pb, acc[mt][1], 0, 0, 0); }
    }
#pragma unroll
    for (int mt = 0; mt < 4; ++mt) { float ss = 0.f;
#pragma unroll
        for (int nt = 0; nt < 2; ++nt) { const f32x4 x = acc[mt][nt]; ss += (x[0] * x[0] + x[1] * x[1]) + (x[2] * x[2] + x[3] * x[3]); }
        ss += __shfl_xor(ss, 16); ss += __shfl_xor(ss, 32);
        if (fq == 0) red_s[wave * 64 + 16 * mt + fr] = ss; }
    __syncthreads();
#pragma unroll
    for (int mt = 0; mt < 4; ++mt) { const int t = 16 * mt + fr; float tot = 0.f;
#pragma unroll
        for (int w = 0; w < 8; ++w) tot += red_s[w * 64 + t];
        const float rstd = 1.0f / sqrtf(tot * (1.0f / HV) + EPS);
#pragma unroll
        for (int nt = 0; nt < 2; ++nt) { const int v = 32 * wave + 16 * nt + 4 * fq;
            const f32x4 gnv = *(const f32x4*)(gn + v);
            const u32x2 gg = gpre[mt][nt];
            const f32x4 x = acc[mt][nt];
            const float g0 = bflo(gg.x), g1 = bfhi(gg.x), g2 = bflo(gg.y), g3 = bfhi(gg.y);
            u32x2 w; w.x = pk2(x[0] * rstd * gnv[0] * pg8::silu_f(g0), x[1] * rstd * gnv[1] * pg8::silu_f(g1));
            w.y = pk2(x[2] * rstd * gnv[2] * pg8::silu_f(g2), x[3] * rstd * gnv[3] * pg8::silu_f(g3));
            *(u32x2*)(Y + (row0 + t) * D + DCONV + hd * HV + v) = w; } }
    __syncthreads();
}

#define XB_TMO      128
#define XB_XCNT(j)  (256  + 64 * (j))
#define XB_XSUB(j)  (1280 + 64 * (j))
#define XB_XGEN(j)  (2304 + 64 * (j))
#define XB_TOP      3328
#define XB_TOPGEN   3392
#define XCD_BAR_WORDS 3456
#define XB_SPIN_CAP (1u << 18)

__device__ __forceinline__ unsigned xb_ld(unsigned* p)              { return __hip_atomic_load(p, __ATOMIC_RELAXED, __HIP_MEMORY_SCOPE_AGENT); }
__device__ __forceinline__ unsigned xb_add(unsigned* p, unsigned v) { return __hip_atomic_fetch_add(p, v, __ATOMIC_RELAXED, __HIP_MEMORY_SCOPE_AGENT); }
__device__ __forceinline__ unsigned xb_xcc_id() { return (unsigned)__builtin_amdgcn_s_getreg((3 << 11) | 20) & 0xFu; }
#define XB_SPIN(cond, bar) do { unsigned _sp = 0; while (cond) { __builtin_amdgcn_s_sleep(1); \
    if ((++_sp & 255u) == 0u) { if (xb_ld(&(bar)[XB_TMO])) break; if (_sp > XB_SPIN_CAP) { atomicAdd(&(bar)[XB_TMO], 1u); break; } } } } while (0)

struct XcdBarrier {
    unsigned* bar; unsigned x;
    volatile LAS unsigned* st;
};

__device__ __forceinline__ XcdBarrier xcd_barrier_post(unsigned* bar, volatile LAS unsigned* st) {
    XcdBarrier b; b.bar = bar; b.x = xb_xcc_id(); b.st = st;
    if (threadIdx.x == 0) (void)xb_add(&bar[XB_XCNT(b.x)], 1u);
    return b;
}
__device__ __forceinline__ void xcd_barrier_complete(unsigned* bar, unsigned x, unsigned& nloc, unsigned& nx) {
    const unsigned G = gridDim.x * gridDim.y * gridDim.z;
    unsigned sum, cnt, mine, sp = 0u;
    for (;;) {
        sum = 0u; cnt = 0u; mine = 0u;
#pragma unroll
        for (unsigned j = 0; j < 16; ++j) { const unsigned c = xb_ld(&bar[XB_XCNT(j)]); sum += c; cnt += (c > 0u) ? 1u : 0u; mine = (j == x) ? c : mine; }
        if (sum == G) break;
        __builtin_amdgcn_s_sleep(1);
        if ((++sp & 255u) == 0u) { if (xb_ld(&bar[XB_TMO])) break; if (sp > XB_SPIN_CAP) { atomicAdd(&bar[XB_TMO], 1u); break; } }
    }
    nloc = mine > 0u ? mine : 1u; nx = cnt > 0u ? cnt : 1u;
}

__device__ __forceinline__ void xcd_barrier(const XcdBarrier& b) {
    asm volatile("s_waitcnt vmcnt(0)" ::: "memory");
    __syncthreads();
    if (threadIdx.x == 0) {
        unsigned* bar = b.bar;
        __builtin_amdgcn_s_waitcnt(0);
        unsigned nloc = b.st[0], nx = b.st[1];
        if (nloc == 0u) { xcd_barrier_complete(bar, b.x, nloc, nx); b.st[0] = nloc; b.st[1] = nx; }
        const unsigned old = xb_add(&bar[XB_XSUB(b.x)], 1u);
        const unsigned gen = old / nloc;
        if (old + 1u == (gen + 1u) * nloc) {
            __builtin_amdgcn_fence(__ATOMIC_RELEASE, "agent");
            asm volatile("s_waitcnt vmcnt(0)" ::: "memory");
            const unsigned og = xb_add(&bar[XB_TOP], 1u);
            const unsigned tg = og / nx;
            if (og + 1u == (tg + 1u) * nx) xb_add(&bar[XB_TOPGEN], 1u);
            else XB_SPIN(xb_ld(&bar[XB_TOPGEN]) == tg, bar);
            __builtin_amdgcn_fence(__ATOMIC_ACQUIRE, "agent");
            xb_add(&bar[XB_XGEN(b.x)], 1u);
            asm volatile("s_waitcnt vmcnt(0)" ::: "memory");
        } else {
            XB_SPIN(xb_ld(&bar[XB_XGEN(b.x)]) == gen, bar);
            __builtin_amdgcn_fence(__ATOMIC_ACQUIRE, "agent");
            asm volatile("s_waitcnt vmcnt(0)" ::: "memory");
        }
    }
    __syncthreads();
}

__global__ void __launch_bounds__(NTHR, 2) fwd_megakernel(Args a) {
    extern __shared__ __attribute__((aligned(16))) unsigned char lds_raw[];
    LAS unsigned char* lds = (LAS unsigned char*)lds_raw;
    cg::grid_group grid = cg::this_grid();
    const int G = gridDim.x, bid = blockIdx.x;
    const int vcu = (G % 8 == 0) ? (bid % 8) * (G / 8) + bid / 8 : bid;
    const int NGW = G * NWAVES, GT = G * NTHR;
    unsigned char* ws = a.ws;
    bf16* XN = (bf16*)(ws + WS_XN); bf16* Hb = (bf16*)(ws + WS_H); bf16* PROJ = (bf16*)(ws + WS_H); bf16* Yb = (bf16*)(ws + WS_Y); bf16* Ub = (bf16*)(ws + WS_U);
    float* BC = (float*)(ws + WS_BC); float* DEC = (float*)(ws + WS_DEC);
    bf16* XB = (bf16*)(ws + WS_XB);
    { volatile LAS unsigned* z = (volatile LAS unsigned*)(lds + 131072); if (threadIdx.x < 64) z[threadIdx.x] = 0u; }
    __syncthreads();
    const XcdBarrier xbar = xcd_barrier_post((unsigned*)(ws + WS_CTL), (volatile LAS unsigned*)(lds + 131072 + 64));
#define GRID_SYNC() xcd_barrier(xbar)
#define GRID_SYNC0() grid.sync()
#define PHASE_IDS int tid = threadIdx.x; asm volatile("" : "+v"(tid)); const int lane = tid & 63, wave = __builtin_amdgcn_readfirstlane(tid >> 6), gw = vcu * NWAVES + wave, gtid = bid * NTHR + tid; (void)lane; (void)wave; (void)gw; (void)gtid;

#pragma unroll 1
    for (int l = 0; l < 2; ++l) {
        if (l == 0) { PHASE_IDS cast_phase(a.in[0], XB, gw, NGW, lane); }
        { PHASE_IDS convert_phase(&a, l, lds, gw, NGW, wave, lane, gtid, GT); }
#pragma unroll 1
        for (int f = 0; f < 2; ++f) {
            if (l == 0 && f == 0) GRID_SYNC0(); { PHASE_IDS norm_phase(XB, (f == 0 ? a.in[1] : a.in[12]) + (size_t)l * D, XN, gw, NGW, lane); }
            GRID_SYNC();
            { pg8::Gemm g{XN, (const bf16*)(ws + (f == 0 ? WS_F1UP : WS_F2UP)), T, NUP, D}; pg8::StaticOrder S; S.init(T, NUP, G, bid);
              pg8::EpiSwiglu E{Hb, FF};
              _Pragma("unroll 1") for (int rep = 0; rep < REP_GEMM; ++rep)
              pg8::gemm_phase<pg8::EpiSwiglu, pg8::StaticOrder, true, true>(lds, g, S, E); }
            GRID_SYNC();
            { pg8::Gemm g{Hb, (const bf16*)(ws + (f == 0 ? WS_F1DN : WS_F2DN)), T, D, FF}; pg8::StaticOrder S; S.init(T, D, G, bid);
              pg8::EpiResid E{XB, D, 0.5f};
              pg8::gemm_phase<pg8::EpiResid, pg8::StaticOrder, true, true>(lds, g, S, E); }
            GRID_SYNC();
            if (f == 0) {
                { PHASE_IDS norm_phase(XB, a.in[5] + (size_t)l * D, XN, gw, NGW, lane); }
                GRID_SYNC();
                { pg8::Gemm g{XN, (const bf16*)(ws + WS_WIN), T, C_ZL, D}; pg8::StaticOrder S; S.init(T, C_ZL, G, bid);
                  pg8::EpiStoreBf16 E{PROJ, NIN};
                  _Pragma("unroll 1") for (int rep = 0; rep < REP_GEMM; ++rep)
                  pg8::gemm_phase<pg8::EpiStoreBf16, pg8::StaticOrder, true, true>(lds, g, S, E); }
                GRID_SYNC();
#pragma unroll 1
                for (int c = bid; c < NCH; c += G) { gla_zl_chunk(XN, (const bf16*)(ws + WS_WIN) + (size_t)C_ZL * D, lds, c, threadIdx.x);
                    gla1_chunk(PROJ, a.in[8] + (size_t)l * RANK * DQK, a.in[9] + (size_t)l * DQK, Ub, BC, DEC, lds, c, threadIdx.x); }
                GRID_SYNC();
                { PHASE_IDS if (tid < 256) scan_phase(Ub, Ub, DEC, bid, G, tid); else conv_phase(PROJ, a.in[7] + (size_t)l * 3 * DCONV, Yb, bid * 256 + (tid - 256), G * 256); }
                GRID_SYNC();
#pragma unroll 1
                for (int id = bid; id < REP_GLA * NCH * NH; id += G) gla3_tile(PROJ, Ub, BC, a.in[10] + (size_t)l * HV, Yb, lds, (id >> 2) & 255, id & 3, threadIdx.x);
                GRID_SYNC();
                { pg8::Gemm g{Yb, (const bf16*)(ws + WS_WOUT), T, D, D}; pg8::StaticOrder S; S.init(T, D, G, bid);
                  pg8::EpiResid E{XB, D, 1.0f};
                  pg8::gemm_phase<pg8::EpiResid, pg8::StaticOrder, true, true>(lds, g, S, E); }
                GRID_SYNC();
            }
        }
    }
    { PHASE_IDS final_norm_phase(XB, a.in[16], a.out, gw, NGW, lane); }
}

extern "C" void kernel_launch(void* const* d_in, const int* in_sizes, int n_in, void* d_out, int out_size, void* d_ws, size_t ws_size, hipStream_t stream) {
    static int grid = 0;
    if (grid == 0) {
        if (n_in != 17 || out_size != T * D || ws_size < WS_END) { fprintf(stderr, "kernel_launch: unexpected sizes n_in %d out %d ws %zu\n", n_in, out_size, ws_size); grid = -1; return; }
        int dev = 0, cus = 0, per_cu = 0;
        hipGetDevice(&dev); hipDeviceGetAttribute(&cus, hipDeviceAttributeMultiprocessorCount, dev);
        if (hipFuncSetAttribute((const void*)fwd_megakernel, hipFuncAttributeMaxDynamicSharedMemorySize, LDS_BYTES) != hipSuccess) { fprintf(stderr, "kernel_launch: hipFuncSetAttribute failed\n"); grid = -1; return; }
        if (hipOccupancyMaxActiveBlocksPerMultiprocessor(&per_cu, (const void*)fwd_megakernel, NTHR, LDS_BYTES) != hipSuccess || per_cu < 1) per_cu = 1;
        (void)hipGetLastError();
        grid = cus * per_cu;
    }
    if (grid < 0) return;
    Args a{};
    for (int i = 0; i < 17; ++i) a.in[i] = (const float*)d_in[i];
    a.out = (float*)d_out; a.ws = (unsigned char*)d_ws;
    if (hipMemsetAsync((char*)d_ws + WS_CTL, 0, CTL_BYTES, stream) != hipSuccess) { fprintf(stderr, "kernel_launch: memset failed\n"); return; }
    void* args[] = {&a};
    hipError_t e = hipLaunchCooperativeKernel((const void*)fwd_megakernel, dim3(grid), dim3(NTHR), args, LDS_BYTES, stream);
    if (e != hipSuccess) fprintf(stderr, "cooperative launch failed: %s (grid %d)\n", hipGetErrorString(e), grid);
}
```

```cpp
#include <hip/hip_runtime.h>
#include <hip/hip_cooperative_groups.h>
#include <cstdio>
#include <cstdint>
namespace pg8 {
#define PG8_LAS __attribute__((address_space(3)))
typedef unsigned short bf16_t;
typedef short bf16x8 __attribute__((ext_vector_type(8)));
typedef float f32x4 __attribute__((ext_vector_type(4)));
typedef unsigned u32x4 __attribute__((ext_vector_type(4)));
constexpr int BM = 256, BK = 64, HALF = 128, HTB = HALF * BK * 2  , STAGE_BYTES = 8 * HTB, NXCD = 8, WGM = 8;

__host__ __device__ __forceinline__ int lds_byte(int r, int c) { const int st = (r >> 4) * 2 + (c >> 5), rr = r & 15, cc = c & 31, ob = rr * 64 + cc * 2; return st * 1024 + (ob ^ (((ob >> 9) & 1) << 5)); }
__host__ __device__ __forceinline__ void stage_rc(int b, int& R, int& C) { const int st = b / 1024, sb = b % 1024, swz = sb ^ (((sb >> 9) & 1) << 5); R = (st >> 1) * 16 + swz / 64; C = (st & 1) * 32 + (swz % 64) / 2; }
__host__ __device__ __forceinline__ int perm32(int rho) { const int n = rho >> 4, i = rho & 15; return 8 * (i >> 2) + 4 * n + (i & 3); }

struct Unit { int pm, pn; };
struct Gemm { const bf16_t* A; const bf16_t* Bt; int M, N, K; };

struct StaticOrder {
    int nM, nN, nwg, G, c;
    __host__ __device__ void init(int M, int N, int G_, int c_) { nM = M / BM; nN = N / BM; nwg = nM * nN; G = G_; c = c_; }
    __host__ __device__ bool next(int i, Unit& u) const {
        const long L = (long)i * G + c; if (L >= nwg) return false;
        int wgid = (int)L; { const int q = nwg / NXCD, r = nwg % NXCD, xcd = wgid % NXCD, off = wgid / NXCD; wgid = (xcd < r ? xcd * (q + 1) : r * (q + 1) + (xcd - r) * q) + off; }
        const int nig = WGM * nN, gid = wgid / nig, fm = gid * WGM, gsz = (nM - fm) < WGM ? (nM - fm) : WGM;
        u.pm = fm + ((wgid % nig) % gsz); u.pn = (wgid % nig) / gsz; return true;
    }
    __device__ __forceinline__ void a_ready(const Unit&) const {}
    __device__ __forceinline__ void done(const Unit&) const {}
};
__device__ __forceinline__ unsigned cvt_pk_bf16(float lo, float hi) { unsigned r; asm volatile("v_cvt_pk_bf16_f32 %0, %1, %2" : "=v"(r) : "v"(lo), "v"(hi)); return r; }
typedef float f32x2 __attribute__((ext_vector_type(2)));
__device__ __forceinline__ float silu_f(float g) { return g * __builtin_amdgcn_rcpf(1.0f + __expf(-g)); }
struct EpiSwiglu {
    static constexpr bool PERM = true, AFTER_DRAIN = false;
    bf16_t* H; int ldh;
    __device__ __forceinline__ void prefetch(const Unit&, int, int, PG8_LAS unsigned char*) const {}
    __device__ __forceinline__ void operator()(const f32x4 (&acc)[2][2][4][2], const Unit& u, int wr, int wc, int fr, int fq, PG8_LAS unsigned char*) const {
        const int row0 = u.pm * BM + wr * 64 + fr, col0 = u.pn * HALF + wc * 32 + 8 * fq;
#pragma unroll
        for (int ai = 0; ai < 2; ++ai)
#pragma unroll
            for (int m = 0; m < 4; ++m) { bf16_t* rowp = H + (size_t)(row0 + ai * HALF + m * 16) * ldh + col0;
                const f32x4 g0 = acc[ai][0][m][0], g1 = acc[ai][0][m][1], u0 = acc[ai][1][m][0], u1 = acc[ai][1][m][1];
                u32x4 w;
                w.x = cvt_pk_bf16(silu_f(g0[0]) * u0[0], silu_f(g0[1]) * u0[1]); w.y = cvt_pk_bf16(silu_f(g0[2]) * u0[2], silu_f(g0[3]) * u0[3]);
                w.z = cvt_pk_bf16(silu_f(g1[0]) * u1[0], silu_f(g1[1]) * u1[1]); w.w = cvt_pk_bf16(silu_f(g1[2]) * u1[2], silu_f(g1[3]) * u1[3]);
                *(u32x4*)rowp = w; }
    }
};
struct EpiStoreBf16 {
    static constexpr bool PERM = true, AFTER_DRAIN = false;
    bf16_t* O; int ldc;
    __device__ __forceinline__ void prefetch(const Unit&, int, int, PG8_LAS unsigned char*) const {}
    __device__ __forceinline__ void operator()(const f32x4 (&acc)[2][2][4][2], const Unit& u, int wr, int wc, int fr, int fq, PG8_LAS unsigned char*) const {
        const int row0 = u.pm * BM + wr * 64 + fr, col0 = u.pn * BM + wc * 32 + 8 * fq;
#pragma unroll
        for (int ai = 0; ai < 2; ++ai)
#pragma unroll
            for (int m = 0; m < 4; ++m) { bf16_t* rowp = O + (size_t)(row0 + ai * HALF + m * 16) * ldc + col0;
#pragma unroll
                for (int bj = 0; bj < 2; ++bj) { const f32x4 v0 = acc[ai][bj][m][0], v1 = acc[ai][bj][m][1];
                    u32x4 w; w.x = cvt_pk_bf16(v0[0], v0[1]); w.y = cvt_pk_bf16(v0[2], v0[3]); w.z = cvt_pk_bf16(v1[0], v1[1]); w.w = cvt_pk_bf16(v1[2], v1[3]);
                    *(u32x4*)(rowp + bj * HALF) = w; } }
    }
};
struct EpiResid {
    static constexpr bool PERM = true, AFTER_DRAIN = false;
    bf16_t* xb; int ldc; float scale;
    __device__ __forceinline__ void prefetch(const Unit&, int, int, PG8_LAS unsigned char*) const {}
    __device__ __forceinline__ void operator()(const f32x4 (&acc)[2][2][4][2], const Unit& u, int wr, int wc, int fr, int fq, PG8_LAS unsigned char*) const {
        const int row0 = u.pm * BM + wr * 64 + fr, col0 = u.pn * BM + wc * 32 + 8 * fq;
#pragma unroll
        for (int ai = 0; ai < 2; ++ai)
#pragma unroll
        for (int mh = 0; mh < 2; ++mh) {
            u32x4 r[2][2];
#pragma unroll
            for (int m2 = 0; m2 < 2; ++m2) { const size_t off = (size_t)(row0 + ai * HALF + (2 * mh + m2) * 16) * ldc + col0;
#pragma unroll
                for (int bj = 0; bj < 2; ++bj) r[m2][bj] = *(const u32x4*)(xb + off + bj * HALF); }
#pragma unroll
            for (int m2 = 0; m2 < 2; ++m2) { const int m = 2 * mh + m2; const size_t off = (size_t)(row0 + ai * HALF + m * 16) * ldc + col0;
#pragma unroll
                for (int bj = 0; bj < 2; ++bj) {
                    const u32x4 q = r[m2][bj]; f32x4 o0, o1;
                    o0[0] = __uint_as_float(q.x << 16); o0[1] = __uint_as_float(q.x & 0xffff0000u); o0[2] = __uint_as_float(q.y << 16); o0[3] = __uint_as_float(q.y & 0xffff0000u);
                    o1[0] = __uint_as_float(q.z << 16); o1[1] = __uint_as_float(q.z & 0xffff0000u); o1[2] = __uint_as_float(q.w << 16); o1[3] = __uint_as_float(q.w & 0xffff0000u);
                    o0 = o0 + acc[ai][bj][m][0] * scale; o1 = o1 + acc[ai][bj][m][1] * scale;
                    u32x4 w; w.x = cvt_pk_bf16(o0[0], o0[1]); w.y = cvt_pk_bf16(o0[2], o0[3]); w.z = cvt_pk_bf16(o1[0], o1[1]); w.w = cvt_pk_bf16(o1[2], o1[3]);
                    *(u32x4*)(xb + off + bj * HALF) = w; } }
            asm volatile("" ::: "memory"); }
    }
};
template <class Epi, class Sched, bool ALIGN_EPI = false, bool SP2 = false>
__device__ __forceinline__ void gemm_phase(PG8_LAS unsigned char* lds, const Gemm g, const Sched& S, const Epi& E) {
    int tid_ = threadIdx.x; asm volatile("" : "+v"(tid_)); const int tid = tid_, wid = __builtin_amdgcn_readfirstlane(tid >> 6), lane = tid & 63, wr = wid >> 2, wc = wid & 3, fr = lane & 15, fq = lane >> 4;
    const int K = g.K, nt = K / BK;
    unsigned voffA[2], voffB[2];
#pragma unroll
    for (int i = 0; i < 2; ++i) { int R, C; stage_rc(tid * 16 + i * 8192, R, C); const int Rb = Epi::PERM ? ((R & ~31) + perm32(R & 31)) : R;
        voffA[i] = (unsigned)(R * K + C) * 2u; voffB[i] = (unsigned)(Rb * K + C) * 2u; }
    const size_t kstep = (size_t)(BK * 2);
    const size_t hstep = (size_t)HALF * K * 2;
    const size_t tstep = 2 * hstep;
    const unsigned ldsw = (unsigned)wid * 1024u;
    const int aoff = lds_byte(wr * 64 + fr, fq * 8), boff = lds_byte(wc * 32 + fr, fq * 8);
#define PG8_SA(b, h) (((b) * 2 + (h)) * HTB)
#define PG8_SB(b, h) ((4 + (b) * 2 + (h)) * HTB)
#define PG8_STAGE(bufoff, gbase, voff) do { _Pragma("unroll") for (int _i = 0; _i < 2; ++_i) \
        __builtin_amdgcn_global_load_lds((const unsigned*)((const char*)(gbase) + (voff)[_i]), (PG8_LAS unsigned*)(lds + (bufoff) + ldsw + _i * 8192), 16, 0, 0); } while (0)
#define PG8_LDA(dst, b, h) do { _Pragma("unroll") for (int m = 0; m < 4; ++m) _Pragma("unroll") for (int k = 0; k < 2; ++k) dst[m][k] = *(const PG8_LAS bf16x8*)(lds + PG8_SA(b, h) + aoff + m * 2048 + k * 1024); } while (0)
#define PG8_LDB(dst, b, h) do { _Pragma("unroll") for (int n = 0; n < 2; ++n) _Pragma("unroll") for (int k = 0; k < 2; ++k) dst[n][k] = *(const PG8_LAS bf16x8*)(lds + PG8_SB(b, h) + boff + n * 2048 + k * 1024); } while (0)
#define PG8_MMA(ai, bj, At, Bt) do { __builtin_amdgcn_s_setprio(1); _Pragma("unroll") for (int m = 0; m < 4; ++m) _Pragma("unroll") for (int n = 0; n < 2; ++n) _Pragma("unroll") for (int k = 0; k < 2; ++k) \
        acc[ai][bj][m][n] = __builtin_amdgcn_mfma_f32_16x16x32_bf16(Bt[n][k], At[m][k], acc[ai][bj][m][n], 0, 0, 0); __builtin_amdgcn_s_setprio(0); } while (0)
#define PG8_WAIT_V(n) asm volatile("s_waitcnt vmcnt(" #n ")" ::: "memory")
#define PG8_WAIT_L(n) asm volatile("s_waitcnt lgkmcnt(" #n ")" ::: "memory")
#define PG8_BAR __builtin_amdgcn_s_barrier()
#define PG8_SCHED __builtin_amdgcn_sched_barrier(0)
    Unit cur, nxt; int ui = 0;
    if (!S.next(0, cur)) return;
    f32x4 acc[2][2][4][2];
#pragma unroll
    for (int a = 0; a < 2; ++a)
#pragma unroll
        for (int b = 0; b < 2; ++b)
#pragma unroll
            for (int m = 0; m < 4; ++m)
#pragma unroll
                for (int n = 0; n < 2; ++n) acc[a][b][m][n] = (f32x4){0.f, 0.f, 0.f, 0.f};
    bf16x8 At[4][2], B0[2][2], B1[2][2];
    const char* cA = (const char*)g.A + (size_t)cur.pm * tstep; const char* cB = (const char*)g.Bt + (size_t)cur.pn * tstep;
    S.a_ready(cur);
    if constexpr (SP2) {
        PG8_STAGE(PG8_SB(0, 0), cB, voffB); PG8_STAGE(PG8_SB(0, 1), cB + hstep, voffB); PG8_STAGE(PG8_SA(0, 0), cA, voffA); PG8_STAGE(PG8_SA(0, 1), cA + hstep, voffA);
        if (wr == 1) PG8_BAR;
        PG8_WAIT_V(2); PG8_BAR;
        PG8_STAGE(PG8_SB(1, 0), cB + kstep, voffB); PG8_STAGE(PG8_SA(1, 0), cA + kstep, voffA); PG8_STAGE(PG8_SB(1, 1), cB + hstep + kstep, voffB);
        PG8_WAIT_V(6); PG8_BAR;
    } else {
        PG8_STAGE(PG8_SB(0, 0), cB, voffB); PG8_STAGE(PG8_SA(0, 0), cA, voffA); PG8_STAGE(PG8_SB(0, 1), cB + hstep, voffB); PG8_STAGE(PG8_SA(0, 1), cA + hstep, voffA);
        if (wr == 1) PG8_BAR;
        PG8_WAIT_V(4); PG8_BAR;
        PG8_STAGE(PG8_SB(1, 0), cB + kstep, voffB); PG8_STAGE(PG8_SA(1, 0), cA + kstep, voffA); PG8_STAGE(PG8_SB(1, 1), cB + hstep + kstep, voffB);
        PG8_WAIT_V(6); PG8_BAR;
    }
    for (;;) {
        const bool has_next = S.next(ui + 1, nxt);
        const char* nA = has_next ? (const char*)g.A + (size_t)nxt.pm * tstep : cA; const char* nB = has_next ? (const char*)g.Bt + (size_t)nxt.pn * tstep : cB;
        for (int t = 0; t < nt; t += 2) {
            const bool last = (t == nt - 2);
            const char* a1 = cA + (size_t)(t + 1) * kstep;
            const char* a2 = last ? nA : cA + (size_t)(t + 2) * kstep; const char* b2 = last ? nB : cB + (size_t)(t + 2) * kstep;
            const char* a3 = a2 + kstep; const char* b3 = b2 + kstep;
            if (last && has_next) S.a_ready(nxt);
            if (last) E.prefetch(cur, wid, lane, lds + STAGE_BYTES + 1024);
            if constexpr (SP2) {
            PG8_LDB(B0, 0, 0); PG8_LDB(B1, 0, 1); PG8_SCHED; PG8_LDA(At, 0, 0); PG8_STAGE(PG8_SA(1, 1), a1 + hstep, voffA);
            PG8_WAIT_V(8); PG8_WAIT_L(0); PG8_BAR; PG8_MMA(0, 0, At, B0); PG8_MMA(0, 1, At, B1); PG8_BAR; PG8_SCHED;
            PG8_LDA(At, 0, 1); PG8_STAGE(PG8_SB(0, 0), b2, voffB); PG8_STAGE(PG8_SB(0, 1), b2 + hstep, voffB); PG8_STAGE(PG8_SA(0, 0), a2, voffA);
            PG8_WAIT_V(8); PG8_WAIT_L(0); PG8_BAR; PG8_MMA(1, 0, At, B0); PG8_MMA(1, 1, At, B1); PG8_BAR; PG8_SCHED;
            PG8_LDB(B0, 1, 0); PG8_LDB(B1, 1, 1); PG8_SCHED; PG8_LDA(At, 1, 0); PG8_STAGE(PG8_SA(0, 1), a2 + hstep, voffA);
            PG8_WAIT_V(8); PG8_WAIT_L(0); PG8_BAR; PG8_MMA(0, 0, At, B0); PG8_MMA(0, 1, At, B1); PG8_BAR; PG8_SCHED;
            PG8_LDA(At, 1, 1); PG8_STAGE(PG8_SB(1, 0), b3, voffB); PG8_STAGE(PG8_SB(1, 1), b3 + hstep, voffB); PG8_STAGE(PG8_SA(1, 0), a3, voffA);
            PG8_WAIT_V(8); PG8_WAIT_L(0); PG8_BAR; PG8_MMA(1, 0, At, B0); PG8_MMA(1, 1, At, B1); PG8_BAR; PG8_SCHED;
            } else {
            PG8_LDB(B0, 0, 0); PG8_SCHED; PG8_LDA(At, 0, 0); PG8_STAGE(PG8_SA(1, 1), a1 + hstep, voffA);
            PG8_WAIT_L(8); PG8_BAR; PG8_WAIT_L(0); PG8_MMA(0, 0, At, B0); PG8_BAR; PG8_SCHED;
            PG8_LDB(B1, 0, 1); PG8_STAGE(PG8_SB(0, 0), b2, voffB);
            PG8_BAR; PG8_WAIT_L(0); PG8_MMA(0, 1, At, B1); PG8_BAR;
            PG8_LDA(At, 0, 1); PG8_STAGE(PG8_SA(0, 0), a2, voffA);
            PG8_BAR; PG8_WAIT_L(0); PG8_MMA(1, 0, At, B0); PG8_BAR; PG8_SCHED;
            PG8_STAGE(PG8_SB(0, 1), b2 + hstep, voffB);
            PG8_WAIT_V(6); PG8_BAR; PG8_MMA(1, 1, At, B1); PG8_BAR;
            PG8_LDB(B0, 1, 0); PG8_SCHED; PG8_LDA(At, 1, 0); PG8_STAGE(PG8_SA(0, 1), a2 + hstep, voffA);
            PG8_WAIT_L(8); PG8_BAR; PG8_WAIT_L(0); PG8_MMA(0, 0, At, B0); PG8_BAR; PG8_SCHED;
            PG8_LDB(B1, 1, 1); PG8_STAGE(PG8_SB(1, 0), b3, voffB);
            PG8_BAR; PG8_WAIT_L(0); PG8_MMA(0, 1, At, B1); PG8_BAR;
            PG8_LDA(At, 1, 1); PG8_STAGE(PG8_SA(1, 0), a3, voffA);
            PG8_BAR; PG8_WAIT_L(0); PG8_MMA(1, 0, At, B0); PG8_BAR; PG8_SCHED;
            PG8_STAGE(PG8_SB(1, 1), b3 + hstep, voffB);
            PG8_WAIT_V(6); PG8_BAR; PG8_MMA(1, 1, At, B1); PG8_BAR;
            }
        }
        if constexpr (ALIGN_EPI) { if (wr == 0) PG8_BAR; }
        if constexpr (!Epi::AFTER_DRAIN) { E(acc, cur, wr, wc, fr, fq, lds + STAGE_BYTES + 1024); S.done(cur); }
        if (!has_next) break;
#pragma unroll
        for (int a = 0; a < 2; ++a)
#pragma unroll
            for (int b = 0; b < 2; ++b)
#pragma unroll
                for (int m = 0; m < 4; ++m)
#pragma unroll
                    for (int n = 0; n < 2; ++n) acc[a][b][m][n] = (f32x4){0.f, 0.f, 0.f, 0.f};
        cur = nxt; cA = nA; cB = nB; ++ui;
        if constexpr (ALIGN_EPI) { if (wr == 1) PG8_BAR; }
    }
    PG8_WAIT_V(0);
    if constexpr (!ALIGN_EPI) { if (wr == 0) PG8_BAR; }
    PG8_BAR;
    if constexpr (Epi::AFTER_DRAIN) { E.fused(acc, cur, wr, wc, fr, fq, lds, wid, lane); S.done(cur); }
#undef PG8_SA
#undef PG8_SB
#undef PG8_STAGE
#undef PG8_LDA
#undef PG8_LDB
#undef PG8_MMA
#undef PG8_WAIT_V
#undef PG8_WAIT_L
#undef PG8_BAR
#undef PG8_SCHED
}
}

namespace cg = cooperative_groups;
#define LAS __attribute__((address_space(3)))
typedef unsigned short bf16;
typedef unsigned u32x4 __attribute__((ext_vector_type(4)));
typedef unsigned u32x2 __attribute__((ext_vector_type(2)));
typedef float f32x4 __attribute__((ext_vector_type(4)));
typedef float f32x2 __attribute__((ext_vector_type(2)));
typedef short bf16x8 __attribute__((ext_vector_type(8)));
constexpr int NWAVES = 8, NTHR = 512;
constexpr int T = 16384, D = 2048, FF = 5632, NUP = 2 * FF, NINV = 6160, NIN = 6400;
constexpr int DCONV = 1024, DQK = 512, DGLA = 1024, HK = 128, HV = 256, NH = 4, RANK = 16, CH = 64, NCH = T / CH;
constexpr int C_XV = 0, C_GB = 1024, C_GC = 2048, C_Q = 3072, C_K = 3584, C_V = 4096, C_G = 5120, C_ZL = 6144;
constexpr float EPS = 1e-6f;
constexpr size_t MiB = 1u << 20;
constexpr size_t WS_F1UP = 0, WS_F1DN = 44 * MiB, WS_F2UP = 66 * MiB, WS_F2DN = 110 * MiB, WS_WIN = 132 * MiB, WS_WOUT = 157 * MiB;
constexpr size_t WS_XN = 166 * MiB, WS_H = 230 * MiB  , WS_Y = 430 * MiB, WS_U = 494 * MiB, WS_BC = 558 * MiB, WS_DEC = 590 * MiB, WS_CTL = 590 * MiB + 512 * 1024, CTL_BYTES = 16384, WS_XB = 594 * MiB  , WS_DUMMY = 658 * MiB, WS_END = 722 * MiB;
#ifndef REP_GEMM
#define REP_GEMM 1
#endif
#ifndef REP_CN
#define REP_CN 1
#endif
#ifndef REP_SCAN
#define REP_SCAN 1
#endif
#ifndef REP_GLA
#define REP_GLA 1
#endif
constexpr int LDS_BYTES = 135168;

__device__ __forceinline__ float bflo(unsigned u) { return __uint_as_float(u << 16); }
__device__ __forceinline__ float bfhi(unsigned u) { return __uint_as_float(u & 0xffff0000u); }
__device__ __forceinline__ float bf2f(unsigned short b) { return __uint_as_float(((unsigned)b) << 16); }
__device__ __forceinline__ unsigned pk2(float lo, float hi) { return pg8::cvt_pk_bf16(lo, hi); }
__device__ __forceinline__ float wave_sum(float v) {
#pragma unroll
    for (int o = 1; o < 64; o <<= 1) v += __shfl_xor(v, o);
    return v;
}
#define LDS_WAIT() asm volatile("s_waitcnt lgkmcnt(0)" ::: "memory")

struct Args { const float* in[17]; float* out; unsigned char* ws; };
typedef const Args* ArgP;
struct CvItem { const float* W; int K, N; bf16* WT; int dst_row0, k0, n0; const float* gain; };
__device__ __forceinline__ CvItem cv_decode(ArgP ap, int l, int it) {
    constexpr int I_UP = (D / 64) * (FF / 32);
    constexpr int NB_IN = (NINV + 31) / 32;
    constexpr int I_IN = (D / 64) * NB_IN;
    unsigned char* ws = ap->ws; CvItem c; int r = it;
    if (r < 6 * I_UP) {
        const int which = r / I_UP; r -= which * I_UP;
        const int f = which / 3, w3 = which % 3;
        c.W = (f == 0 ? (w3 == 0 ? ap->in[2] : (w3 == 1 ? ap->in[3] : ap->in[4])) : (w3 == 0 ? ap->in[13] : (w3 == 1 ? ap->in[14] : ap->in[15]))) + (size_t)l * D * FF;
        if (w3 < 2) { const int nblk = FF / 32, kb = r / nblk, nb = r % nblk; c.n0 = nb * 32; c.k0 = kb * 64; c.K = D; c.N = FF;
            c.WT = (bf16*)(ws + (f == 0 ? WS_F1UP : WS_F2UP)); c.dst_row0 = (c.n0 >> 7) * 256 + (c.n0 & 127) + (w3 == 1 ? 128 : 0); c.gain = nullptr; }
        else { const int nblk = D / 32, kb = r / nblk, nb = r % nblk; c.n0 = nb * 32; c.k0 = kb * 64; c.K = FF; c.N = D;
            c.WT = (bf16*)(ws + (f == 0 ? WS_F1DN : WS_F2DN)); c.dst_row0 = c.n0; c.gain = nullptr; }
        return c;
    }
    r -= 6 * I_UP;
    if (r < I_IN) { const int kb = r / NB_IN, nb = r % NB_IN; c.n0 = nb * 32; c.k0 = kb * 64; c.K = D; c.N = NINV; c.W = ap->in[6] + (size_t)l * D * NINV; c.WT = (bf16*)(ws + WS_WIN); c.dst_row0 = c.n0; c.gain = nullptr; return c; }
    r -= I_IN;
    { const int nblk = D / 32, kb = r / nblk, nb = r % nblk; c.n0 = nb * 32; c.k0 = kb * 64; c.K = D; c.N = D; c.W = ap->in[11] + (size_t)l * D * D; c.WT = (bf16*)(ws + WS_WOUT); c.dst_row0 = c.n0; c.gain = nullptr; }
    return c;
}
__device__ __forceinline__ void cv_load(const CvItem& c, int lane, f32x4 (&v)[8]) {
    const int col4 = (lane & 7) * 4; const bool ok = (c.n0 + col4) < c.N;
    const float* p = c.W + (size_t)(c.k0 + (lane >> 3)) * c.N + c.n0 + col4;
#pragma unroll
    for (int i = 0; i < 8; ++i) v[i] = ok ? __builtin_nontemporal_load((const f32x4*)(p + (size_t)(8 * i) * c.N)) : (f32x4){0.f, 0.f, 0.f, 0.f};
}
__device__ __forceinline__ void cv_process(const CvItem& c, int lane, const f32x4 (&v)[8], LAS float* scr) {
    const int col4 = (lane & 7) * 4, r0 = lane >> 3, cc = lane & 7;
    f32x4 g0 = (f32x4){1.f, 1.f, 1.f, 1.f}, g1 = g0;
    if (c.gain) { g0 = *(const f32x4*)(c.gain + c.k0 + 8 * cc); g1 = *(const f32x4*)(c.gain + c.k0 + 8 * cc + 4); }
#pragma unroll
    for (int i = 0; i < 8; ++i) { LAS float* d = scr + (r0 + 8 * i) * 33 + col4; d[0] = v[i][0]; d[1] = v[i][1]; d[2] = v[i][2]; d[3] = v[i][3]; }
    LDS_WAIT(); asm volatile("" ::: "memory");
#pragma unroll
    for (int j = 0; j < 4; ++j) { const int n = (lane >> 3) + 8 * j; const LAS float* s = scr + (8 * cc) * 33 + n;
        u32x4 o; o.x = pk2(s[0 * 33] * g0[0], s[1 * 33] * g0[1]); o.y = pk2(s[2 * 33] * g0[2], s[3 * 33] * g0[3]); o.z = pk2(s[4 * 33] * g1[0], s[5 * 33] * g1[1]); o.w = pk2(s[6 * 33] * g1[2], s[7 * 33] * g1[3]);
        *(u32x4*)(c.WT + (size_t)(c.dst_row0 + n) * c.K + c.k0 + 8 * cc) = o; }
    LDS_WAIT(); asm volatile("" ::: "memory");
}

__device__ __forceinline__ void convert_phase(ArgP ap, int l, LAS unsigned char* lds, int gw, int NGW, int wave, int lane, int gtid, int GT) {
    LAS float* scr = (LAS float*)(lds + wave * 16384);
    constexpr int I_UP = (D / 64) * (FF / 32), NB_IN = (NINV + 31) / 32, I_IN = (D / 64) * NB_IN, I_OUT = (D / 64) * (D / 32);
    constexpr int NITEMS = 6 * I_UP + I_IN + I_OUT;
    unsigned char* ws = ap->ws;
    int it = gw;
    if (it < NITEMS) {
        CvItem cur = cv_decode(ap, l, it); f32x4 v[8]; cv_load(cur, lane, v);
        for (;;) {
            const int nit = it + NGW; const bool more = nit < NITEMS;
            CvItem nxt = cur; f32x4 vn[8];
            if (more) { nxt = cv_decode(ap, l, nit); cv_load(nxt, lane, vn); }
            cv_process(cur, lane, v, scr);
            if (!more) break;
            cur = nxt; it = nit;
#pragma unroll
            for (int i = 0; i < 8; ++i) v[i] = vn[i];
        }
    }
    { u32x4* p = (u32x4*)(ws + WS_WIN + (size_t)(NB_IN * 32) * D * 2); const int n16 = (NIN - NB_IN * 32) * D * 2 / 16;
      for (int i = gtid; i < n16; i += GT) p[i] = (u32x4){0u, 0u, 0u, 0u}; }
}

__device__ __forceinline__ void cast_phase(const float* x, bf16* xb, int gw, int NGW, int lane) {
    for (int m = gw; m < T; m += NGW) {
        const f32x4* xr = (const f32x4*)(x + (size_t)m * D) + lane; u32x2* o = (u32x2*)(xb + (size_t)m * D) + lane;
#pragma unroll
        for (int j = 0; j < 8; ++j) { const f32x4 v = __builtin_nontemporal_load(xr + 64 * j); u32x2 w; w.x = pk2(v.x, v.y); w.y = pk2(v.z, v.w); o[64 * j] = w; }
    }
}
__device__ __forceinline__ void norm_phase(const bf16* xb, const float* g, bf16* xn, int gw, int NGW, int lane) {
    f32x4 gv[8];
#pragma unroll
    for (int j = 0; j < 4; ++j) { gv[2 * j] = ((const f32x4*)g)[2 * (64 * j + lane)]; gv[2 * j + 1] = ((const f32x4*)g)[2 * (64 * j + lane) + 1]; }
    for (int m = gw; m < T; m += NGW) {
        const u32x4* xr = (const u32x4*)(xb + (size_t)m * D) + lane;
        f32x4 v[8]; float s = 0.f;
#pragma unroll
        for (int j = 0; j < 4; ++j) { const u32x4 q = xr[64 * j];
            v[2 * j] = (f32x4){bflo(q.x), bfhi(q.x), bflo(q.y), bfhi(q.y)}; v[2 * j + 1] = (f32x4){bflo(q.z), bfhi(q.z), bflo(q.w), bfhi(q.w)}; }
#pragma unroll
        for (int j = 0; j < 8; ++j) s += (v[j].x * v[j].x + v[j].y * v[j].y) + (v[j].z * v[j].z + v[j].w * v[j].w);
        const float rstd = 1.0f / sqrtf(wave_sum(s) * (1.0f / D) + EPS);
        u32x4* o = (u32x4*)(xn + (size_t)m * D) + lane;
#pragma unroll
        for (int j = 0; j < 4; ++j) { const f32x4 a = v[2 * j] * rstd * gv[2 * j], b = v[2 * j + 1] * rstd * gv[2 * j + 1];
            u32x4 w; w.x = pk2(a.x, a.y); w.y = pk2(a.z, a.w); w.z = pk2(b.x, b.y); w.w = pk2(b.z, b.w); o[64 * j] = w; }
    }
}
__device__ __forceinline__ void final_norm_phase(const bf16* xb, const float* g, float* out, int gw, int NGW, int lane) {
    f32x4 gv[8];
#pragma unroll
    for (int j = 0; j < 4; ++j) { gv[2 * j] = ((const f32x4*)g)[2 * (64 * j + lane)]; gv[2 * j + 1] = ((const f32x4*)g)[2 * (64 * j + lane) + 1]; }
    for (int m = gw; m < T; m += NGW) {
        const u32x4* xr = (const u32x4*)(xb + (size_t)m * D) + lane;
        f32x4 v[8]; float s = 0.f;
#pragma unroll
        for (int j = 0; j < 4; ++j) { const u32x4 q = xr[64 * j];
            v[2 * j] = (f32x4){bflo(q.x), bfhi(q.x), bflo(q.y), bfhi(q.y)}; v[2 * j + 1] = (f32x4){bflo(q.z), bfhi(q.z), bflo(q.w), bfhi(q.w)}; }
#pragma unroll
        for (int j = 0; j < 8; ++j) s += (v[j].x * v[j].x + v[j].y * v[j].y) + (v[j].z * v[j].z + v[j].w * v[j].w);
        const float rstd = 1.0f / sqrtf(wave_sum(s) * (1.0f / D) + EPS);
        f32x4* o = (f32x4*)(out + (size_t)m * D) + 2 * lane;
#pragma unroll
        for (int j = 0; j < 4; ++j) { __builtin_nontemporal_store(v[2 * j] * rstd * gv[2 * j], o + 128 * j); __builtin_nontemporal_store(v[2 * j + 1] * rstd * gv[2 * j + 1], o + 128 * j + 1); }
    }
}

__device__ __forceinline__ void conv_phase(const bf16* proj, const float* cw  , bf16* Y, int gtid, int GT) {
    for (int id = gtid; id < (T / 16) * (DCONV / 8); id += GT) {
        const int cgp = id & 127, tb = id >> 7, c0 = cgp * 8, t0 = tb * 16;
        float w0[8], w1[8], w2[8], um2[8], um1[8];
#pragma unroll
        for (int j = 0; j < 8; ++j) { w0[j] = cw[c0 + j]; w1[j] = cw[DCONV + c0 + j]; w2[j] = cw[2 * DCONV + c0 + j]; um2[j] = 0.f; um1[j] = 0.f; }
        if (t0 > 0) {
            const u32x4 a2 = *(const u32x4*)(proj + (size_t)(t0 - 2) * NIN + C_XV + c0), b2 = *(const u32x4*)(proj + (size_t)(t0 - 2) * NIN + C_GC + c0);
            const u32x4 a1 = *(const u32x4*)(proj + (size_t)(t0 - 1) * NIN + C_XV + c0), b1 = *(const u32x4*)(proj + (size_t)(t0 - 1) * NIN + C_GC + c0);
#pragma unroll
            for (int j = 0; j < 4; ++j) { um2[2 * j] = bflo(a2[j]) * bflo(b2[j]); um2[2 * j + 1] = bfhi(a2[j]) * bfhi(b2[j]); um1[2 * j] = bflo(a1[j]) * bflo(b1[j]); um1[2 * j + 1] = bfhi(a1[j]) * bfhi(b1[j]); }
        }
#pragma unroll 8
        for (int i = 0; i < 16; ++i) {
            const size_t ro = (size_t)(t0 + i) * NIN + c0;
            const u32x4 xv = *(const u32x4*)(proj + ro + C_XV), gc = *(const u32x4*)(proj + ro + C_GC), gb = *(const u32x4*)(proj + ro + C_GB);
            float u0[8], y[8];
#pragma unroll
            for (int j = 0; j < 4; ++j) { u0[2 * j] = bflo(xv[j]) * bflo(gc[j]); u0[2 * j + 1] = bfhi(xv[j]) * bfhi(gc[j]); }
#pragma unroll
            for (int j = 0; j < 8; ++j) y[j] = w0[j] * um2[j] + w1[j] * um1[j] + w2[j] * u0[j];
            u32x4 o;
#pragma unroll
            for (int j = 0; j < 4; ++j) o[j] = pk2(y[2 * j] * bflo(gb[j]), y[2 * j + 1] * bfhi(gb[j]));
            *(u32x4*)(Y + (size_t)(t0 + i) * D + c0) = o;
#pragma unroll
            for (int j = 0; j < 8; ++j) { um2[j] = um1[j]; um1[j] = u0[j]; }
        }
    }
}

constexpr int BC_LD = 132;
constexpr int TR_LD = 72;
constexpr int QK_LD = 136;
__device__ __forceinline__ float logsig(float z) { return fminf(z, 0.f) - __logf(1.0f + __expf(-fabsf(z))); }

__device__ __forceinline__ void gla_zl_chunk(const bf16* XN, const bf16* WzlT  , LAS unsigned char* lds, int c, int tid_in) {
    int tid = tid_in; asm volatile("" : "+v"(tid));
    const int lane = tid & 63, wave = tid >> 6, fr = lane & 15, fq = lane >> 4;
    LAS float* zl_s = (LAS float*)lds;
    LAS float* part = (LAS float*)(lds + 48640);
    f32x4 acc[4];
#pragma unroll
    for (int mt = 0; mt < 4; ++mt) acc[mt] = (f32x4){0.f, 0.f, 0.f, 0.f};
    const bf16* ap = XN + (size_t)(c * CH + fr) * D + 256 * wave + fq * 8;
    const bf16* bp = WzlT + (size_t)fr * D + 256 * wave + fq * 8;
#pragma unroll
    for (int ks = 0; ks < 8; ++ks) {
        const bf16x8 b = *(const bf16x8*)(bp + ks * 32);
#pragma unroll
        for (int mt = 0; mt < 4; ++mt) { const bf16x8 a = *(const bf16x8*)(ap + (size_t)(16 * mt) * D + ks * 32);
            acc[mt] = __builtin_amdgcn_mfma_f32_16x16x32_bf16(a, b, acc[mt], 0, 0, 0); }
    }
#pragma unroll
    for (int mt = 0; mt < 4; ++mt)
#pragma unroll
        for (int r = 0; r < 4; ++r) part[(wave * 64 + 16 * mt + 4 * fq + r) * 16 + fr] = acc[mt][r];
    __syncthreads();
#pragma unroll
    for (int i = 0; i < 2; ++i) { const int o = tid + NTHR * i; float s = 0.f;
#pragma unroll
        for (int w = 0; w < 8; ++w) s += part[w * 1024 + o];
        zl_s[o] = s; }
    __syncthreads();
}

struct G1In { f32x4 w2; float gb; u32x4 ka, kb, vpa[2], vpb[2]; };
__device__ __forceinline__ G1In gla1_load(const bf16* proj, const float* gw2, const float* gbias, size_t row0, int hd, int tid) {
    G1In in;
    { const int idx = tid * 4, r = idx >> 7, k = idx & 127; in.w2 = *(const f32x4*)(gw2 + r * DQK + hd * HK + k); }
    in.gb = gbias[hd * HK + (tid & 127)];
    const int ps0 = (tid & 31) * 2, pk0 = (tid >> 5) * 8;
    in.ka = *(const u32x4*)(proj + (row0 + ps0) * NIN + C_K + hd * HK + pk0); in.kb = *(const u32x4*)(proj + (row0 + ps0 + 1) * NIN + C_K + hd * HK + pk0);
#pragma unroll
    for (int it = 0; it < 2; ++it) { const int item = tid + NTHR * it, s0 = (item & 31) * 2, v0 = (item >> 5) * 8;
        in.vpa[it] = *(const u32x4*)(proj + (row0 + s0) * NIN + C_V + hd * HV + v0); in.vpb[it] = *(const u32x4*)(proj + (row0 + s0 + 1) * NIN + C_V + hd * HV + v0); }
    return in;
}
__device__ __forceinline__ void gla1_chunk(const bf16* proj, const float* gw2  , const float* gbias  , bf16* U, float* BC, float* DEC,
                                           LAS unsigned char* lds, int c, int tid_in) {
    int tid = tid_in; asm volatile("" : "+v"(tid));
    LAS float* zl_s = (LAS float*)lds;
    LAS float* w2_s = (LAS float*)(lds + 4096);
    LAS float* gb_s = (LAS float*)(lds + 12288);
    LAS float* seg_s = (LAS float*)(lds + 12800);
    LAS float* bc_s = (LAS float*)(lds + 14848);
    LAS bf16* kT_s = (LAS bf16*)(lds + 48640);
    LAS bf16* vT_s = (LAS bf16*)(lds + 67072);
    const int lane = tid & 63, wave = tid >> 6, fr = lane & 15, fq = lane >> 4;
    const size_t row0 = (size_t)c * CH;
    G1In in = gla1_load(proj, gw2, gbias, row0, 0, tid);
#pragma unroll 1
    for (int hd = 0; hd < NH; ++hd) {
        *(LAS f32x4*)(w2_s + tid * 4) = in.w2;
        if (tid < 128) gb_s[tid] = in.gb;
        __syncthreads();
        const int k = tid & 127, tq = tid >> 7;
        {
            float w[16], pre[16]; const float bias = gb_s[k];
#pragma unroll
            for (int r = 0; r < 16; ++r) w[r] = w2_s[r * 128 + k];
            float run = 0.f;
#pragma unroll
            for (int i = 0; i < 16; ++i) { const int t = 16 * tq + i; float z = bias;
                const f32x4 z0 = *(const LAS f32x4*)(zl_s + t * 16), z1 = *(const LAS f32x4*)(zl_s + t * 16 + 4), z2 = *(const LAS f32x4*)(zl_s + t * 16 + 8), z3 = *(const LAS f32x4*)(zl_s + t * 16 + 12);
#pragma unroll
                for (int r = 0; r < 4; ++r) { z += z0[r] * w[r]; }
#pragma unroll
                for (int r = 0; r < 4; ++r) { z += z1[r] * w[4 + r]; }
#pragma unroll
                for (int r = 0; r < 4; ++r) { z += z2[r] * w[8 + r]; }
#pragma unroll
                for (int r = 0; r < 4; ++r) { z += z3[r] * w[12 + r]; }
                run += logsig(z) * (1.0f / 16.0f); pre[i] = run; }
            seg_s[tq * 128 + k] = run;
            __syncthreads();
            float off = 0.f;
#pragma unroll
            for (int q = 0; q < 3; ++q) off += (q < tq) ? seg_s[q * 128 + k] : 0.f;
#pragma unroll
            for (int i = 0; i < 16; ++i) { const int t = 16 * tq + i; const float b = pre[i] + off; bc_s[t * BC_LD + k] = b; BC[(row0 + t) * DQK + hd * HK + k] = b; }
            if (tq == 3) DEC[(size_t)c * DQK + hd * HK + k] = __expf(pre[15] + off);
        }
        __syncthreads();
        { const int s0 = (tid & 31) * 2, k0 = (tid >> 5) * 8;
#pragma unroll
            for (int j = 0; j < 8; ++j) { const float bl = bc_s[63 * BC_LD + k0 + j];
                const float fa = ((j & 1) ? bfhi(in.ka[j >> 1]) : bflo(in.ka[j >> 1])) * __expf(bl - bc_s[s0 * BC_LD + k0 + j]);
                const float fb = ((j & 1) ? bfhi(in.kb[j >> 1]) : bflo(in.kb[j >> 1])) * __expf(bl - bc_s[(s0 + 1) * BC_LD + k0 + j]);
                *(LAS unsigned*)(kT_s + (k0 + j) * TR_LD + s0) = pk2(fa, fb); } }
#pragma unroll
        for (int it = 0; it < 2; ++it) { const int item = tid + NTHR * it, s0 = (item & 31) * 2, v0 = (item >> 5) * 8;
            const u32x4 va = in.vpa[it], vb = in.vpb[it];
#pragma unroll
            for (int p = 0; p < 4; ++p) { *(LAS unsigned*)(vT_s + (v0 + 2 * p) * TR_LD + s0) = (va[p] & 0xffffu) | (vb[p] << 16);
                *(LAS unsigned*)(vT_s + (v0 + 2 * p + 1) * TR_LD + s0) = (va[p] >> 16) | (vb[p] & 0xffff0000u); } }
        __syncthreads();
        f32x4 acc[8][2];
#pragma unroll
        for (int mt = 0; mt < 8; ++mt) { acc[mt][0] = (f32x4){0.f, 0.f, 0.f, 0.f}; acc[mt][1] = (f32x4){0.f, 0.f, 0.f, 0.f}; }
#pragma unroll
        for (int ks = 0; ks < 2; ++ks) {
            bf16x8 vb[2];
#pragma unroll
            for (int nt = 0; nt < 2; ++nt) vb[nt] = *(const LAS bf16x8*)(vT_s + (32 * wave + 16 * nt + fr) * TR_LD + ks * 32 + fq * 8);
#pragma unroll
            for (int mt = 0; mt < 8; ++mt) { const bf16x8 ka = *(const LAS bf16x8*)(kT_s + (16 * mt + fr) * TR_LD + ks * 32 + fq * 8);
                acc[mt][0] = __builtin_amdgcn_mfma_f32_16x16x32_bf16(ka, vb[0], acc[mt][0], 0, 0, 0);
                acc[mt][1] = __builtin_amdgcn_mfma_f32_16x16x32_bf16(ka, vb[1], acc[mt][1], 0, 0, 0); }
        }
        if (hd + 1 < NH) in = gla1_load(proj, gw2, gbias, row0, hd + 1, tid);
        bf16* Ut = U + (size_t)(c * NH + hd) * HV * HK;
#pragma unroll
        for (int mt = 0; mt < 8; ++mt)
#pragma unroll
            for (int nt = 0; nt < 2; ++nt) { u32x2 w; w.x = pk2(acc[mt][nt][0], acc[mt][nt][1]); w.y = pk2(acc[mt][nt][2], acc[mt][nt][3]);
                *(u32x2*)(Ut + (size_t)(32 * wave + 16 * nt + fr) * HK + 16 * mt + 4 * fq) = w; }
        __syncthreads();
    }
}

constexpr int SCAN_B = 32;
__device__ __forceinline__ void scan_phase(bf16* U, bf16* So, const float* DEC, int bid, int G, int tid) {
    if (tid >= 256) return;
    for (int e = bid * 256 + tid; e < NH * HV * (HK / 2); e += G * 256) {
        const int hd = e >> 14, rem = e & 16383, v = rem >> 6, kp = rem & 63;
        unsigned* up = (unsigned*)(U + ((size_t)hd * HV + v) * HK + 2 * kp);
        unsigned* op = (unsigned*)(So + ((size_t)hd * HV + v) * HK + 2 * kp);
        const f32x2* dp = (const f32x2*)(DEC + hd * HK + 2 * kp);
        float s0 = 0.f, s1 = 0.f;
        for (int c0 = 0; c0 < NCH; c0 += SCAN_B) {
            unsigned ub[SCAN_B]; f32x2 db[SCAN_B];
#pragma unroll
            for (int i = 0; i < SCAN_B; ++i) { ub[i] = up[(size_t)(c0 + i) * (NH * HV * HK / 2)]; db[i] = dp[(size_t)(c0 + i) * (DQK / 2)]; }
#pragma unroll
            for (int i = 0; i < SCAN_B; ++i) { op[(size_t)(c0 + i) * (NH * HV * HK / 2)] = pk2(s0, s1); s0 = db[i].x * s0 + bflo(ub[i]); s1 = db[i].y * s1 + bfhi(ub[i]); }
        }
    }
}

__device__ __forceinline__ void gla3_tile(const bf16* proj, const bf16* Sg, const float* BC, const float* gn  , bf16* Y,
                                          LAS unsigned char* lds, int c, int hd, int tid_in) {
    int tid = tid_in; asm volatile("" : "+v"(tid));
    LAS bf16* QE_s = (LAS bf16*)lds;
    LAS bf16* QM_s = (LAS bf16*)(lds + 17408);
    LAS bf16* KD_s = (LAS bf16*)(lds + 34816);
    LAS bf16* KM_s = (LAS bf16*)(lds + 52224);
    LAS bf16* vT_s = (LAS bf16*)(lds + 69632);
    LAS bf16* P_s = (LAS bf16*)(lds + 106496);
    LAS float* red_s = (LAS float*)(lds + 115712);
    const int lane = tid & 63, wave = tid >> 6, fr = lane & 15, fq = lane >> 4;
    const size_t row0 = (size_t)c * CH;
    const float qscale = 0.08838834764831845f;
    const bf16* St = Sg + (size_t)(c * NH + hd) * HV * HK;
    bf16x8 sfr[4][2]; u32x2 gpre[4][2];
#pragma unroll
    for (int ks = 0; ks < 4; ++ks)
#pragma unroll
        for (int nt = 0; nt < 2; ++nt) sfr[ks][nt] = *(const bf16x8*)(St + (size_t)(32 * wave + 16 * nt + fr) * HK + ks * 32 + fq * 8);
#pragma unroll
    for (int mt = 0; mt < 4; ++mt)
#pragma unroll
        for (int nt = 0; nt < 2; ++nt) gpre[mt][nt] = *(const u32x2*)(proj + (row0 + 16 * mt + fr) * NIN + C_G + hd * HV + 32 * wave + 16 * nt + 4 * fq);
#pragma unroll
    for (int it = 0; it < 2; ++it) { const int ch = tid + NTHR * it, s = ch >> 4, k0 = (ch & 15) * 8;
        const u32x4 qv = *(const u32x4*)(proj + (row0 + s) * NIN + C_Q + hd * HK + k0), kv = *(const u32x4*)(proj + (row0 + s) * NIN + C_K + hd * HK + k0);
        const f32x4 b0 = *(const f32x4*)(BC + (row0 + s) * DQK + hd * HK + k0), b1 = *(const f32x4*)(BC + (row0 + s) * DQK + hd * HK + k0 + 4);
        u32x4 qe, qm, kd, km;
#pragma unroll
        for (int j = 0; j < 4; ++j) { const float ba = (j < 2) ? b0[2 * j] : b1[2 * j - 4], bb = (j < 2) ? b0[2 * j + 1] : b1[2 * j - 3];
            const float ea = __expf(ba), eb = __expf(bb), ia = __expf(-ba), ib = __expf(-bb);
            const float qa = bflo(qv[j]) * qscale, qb = bfhi(qv[j]) * qscale, ka = bflo(kv[j]), kb = bfhi(kv[j]);
            qe[j] = pk2(qa * ea, qb * eb); qm[j] = pk2(qa * ia, qb * ib); kd[j] = pk2(ka * ia, kb * ib); km[j] = pk2(ka * ea, kb * eb); }
        *(LAS u32x4*)(QE_s + s * QK_LD + k0) = qe; *(LAS u32x4*)(QM_s + s * QK_LD + k0) = qm; *(LAS u32x4*)(KD_s + s * QK_LD + k0) = kd; *(LAS u32x4*)(KM_s + s * QK_LD + k0) = km; }
#pragma unroll
    for (int it = 0; it < 2; ++it) { const int item = tid + NTHR * it, s0 = (item & 31) * 2, v0 = (item >> 5) * 8;
        const u32x4 va = *(const u32x4*)(proj + (row0 + s0) * NIN + C_V + hd * HV + v0), vb = *(const u32x4*)(proj + (row0 + s0 + 1) * NIN + C_V + hd * HV + v0);
#pragma unroll
        for (int p = 0; p < 4; ++p) { *(LAS unsigned*)(vT_s + (v0 + 2 * p) * TR_LD + s0) = (va[p] & 0xffffu) | (vb[p] << 16);
            *(LAS unsigned*)(vT_s + (v0 + 2 * p + 1) * TR_LD + s0) = (va[p] >> 16) | (vb[p] & 0xffff0000u); } }
    __syncthreads();
#pragma unroll
    for (int pi = 0; pi < 2; ++pi) { const int p = wave + 8 * pi, tt = p >> 2, st = p & 3;
        f32x4 lo = (f32x4){0.f, 0.f, 0.f, 0.f}, hi = (f32x4){0.f, 0.f, 0.f, 0.f};
        if (st <= tt) {
#pragma unroll
            for (int ks = 0; ks < 4; ++ks) { const bf16x8 a = *(const LAS bf16x8*)(KD_s + (16 * st + fr) * QK_LD + ks * 32 + fq * 8), b = *(const LAS bf16x8*)(QE_s + (16 * tt + fr) * QK_LD + ks * 32 + fq * 8);
                lo = __builtin_amdgcn_mfma_f32_16x16x32_bf16(a, b, lo, 0, 0, 0); } }
        if (st >= tt) {
#pragma unroll
            for (int ks = 0; ks < 4; ++ks) { const bf16x8 a = *(const LAS bf16x8*)(KM_s + (16 * st + fr) * QK_LD + ks * 32 + fq * 8), b = *(const LAS bf16x8*)(QM_s + (16 * tt + fr) * QK_LD + ks * 32 + fq * 8);
                hi = __builtin_amdgcn_mfma_f32_16x16x32_bf16(a, b, hi, 0, 0, 0); } }
        const int tabs = 16 * tt + fr, sabs = 16 * st + 4 * fq; float pv[4];
#pragma unroll
        for (int r = 0; r < 4; ++r) pv[r] = (sabs + r <= tabs) ? lo[r] : hi[r];
        u32x2 w; w.x = pk2(pv[0], pv[1]); w.y = pk2(pv[2], pv[3]);
        *(LAS u32x2*)(P_s + tabs * TR_LD + sabs) = w; }
    __syncthreads();
    f32x4 acc[4][2];
#pragma unroll
    for (int mt = 0; mt < 4; ++mt) { acc[mt][0] = (f32x4){0.f, 0.f, 0.f, 0.f}; acc[mt][1] = (f32x4){0.f, 0.f, 0.f, 0.f}; }
#pragma unroll
    for (int ks = 0; ks < 4; ++ks) {
        bf16x8 sa[2]; sa[0] = sfr[ks][0]; sa[1] = sfr[ks][1];
#pragma unroll
        for (int mt = 0; mt < 4; ++mt) { const bf16x8 qb = *(const LAS bf16x8*)(QE_s + (16 * mt + fr) * QK_LD + ks * 32 + fq * 8);
            acc[mt][0] = __builtin_amdgcn_mfma_f32_16x16x32_bf16(sa[0], qb, acc[mt][0], 0, 0, 0);
            acc[mt][1] = __builtin_amdgcn_mfma_f32_16x16x32_bf16(sa[1], qb, acc[mt][1], 0, 0, 0); }
    }
#pragma unroll
    for (int ks = 0; ks < 2; ++ks) {
        bf16x8 va[2];
#pragma unroll
        for (int nt = 0; nt < 2; ++nt) va[nt] = *(const LAS bf16x8*)(vT_s + (32 * wave + 16 * nt + fr) * TR_LD + ks * 32 + fq * 8);
#pragma unroll
        for (int mt = 0; mt < 4; ++mt) { const bf16x8 pb = *(const LAS bf16x8*)(P_s + (16 * mt + fr) * TR_LD + ks * 32 + fq * 8);
            acc[mt][0] = __builtin_amdgcn_mfma_f32_16x16x32_bf16(va[0], pb, acc[mt][0], 0, 0, 0);
            acc[mt][1] = __builtin_amdgcn_mfma_f32_16x16x32_bf16(va[1], pb, acc[mt][1], 0, 0, 0); }
    }
#pragma unroll
    for (int mt = 0; mt < 4; ++mt) { float ss = 0.f;
#pragma unroll
        for (int nt = 0; nt < 2; ++nt) { const f32x4 x = acc[mt][nt]; ss += (x[0] * x[0] + x[1] * x[1]) + (x[2] * x[2] + x[3] * x[3]); }
        ss += __shfl_xor(ss, 16); ss += __shfl_xor(ss, 32);
        if (fq == 0) red_s[wave * 64 + 16 * mt + fr] = ss; }
    __syncthreads();
#pragma unroll
    for (int mt = 0; mt < 4; ++mt) { const int t = 16 * mt + fr; float tot = 0.f;
#pragma unroll
        for (int w = 0; w < 8; ++w) tot += red_s[w * 64 + t];
        const float rstd = 1.0f / sqrtf(tot * (1.0f / HV) + EPS);
#pragma unroll
        for (int nt = 0; nt < 2; ++nt) { const int v = 32 * wave + 16 * nt + 4 * fq;
            const f32x4 gnv = *(const f32x4*)(gn + v);
            const u32x2 gg = gpre[mt][nt];
            const f32x4 x = acc[mt][nt];
            const float g0 = bflo(gg.x), g1 = bfhi(gg.x), g2 = bflo(gg.y), g3 = bfhi(gg.y);
            u32x2 w; w.x = pk2(x[0] * rstd * gnv[0] * pg8::silu_f(g0), x[1] * rstd * gnv[1] * pg8::silu_f(g1));
            w.y = pk2(x[2] * rstd * gnv[2] * pg8::silu_f(g2), x[3] * rstd * gnv[3] * pg8::silu_f(g3));
            *(u32x2*)(Y + (row0 + t) * D + DCONV + hd * HV + v) = w; } }
    __syncthreads();
}

#define XB_TMO      128
#define XB_XCNT(j)  (256  + 64 * (j))
#define XB_XSUB(j)  (1280 + 64 * (j))
#define XB_XGEN(j)  (2304 + 64 * (j))
#define XB_TOP      3328
#define XB_TOPGEN   3392
#define XCD_BAR_WORDS 3456
#define XB_SPIN_CAP (1u << 18)

__device__ __forceinline__ unsigned xb_ld(unsigned* p)              { return __hip_atomic_load(p, __ATOMIC_RELAXED, __HIP_MEMORY_SCOPE_AGENT); }
__device__ __forceinline__ unsigned xb_add(unsigned* p, unsigned v) { return __hip_atomic_fetch_add(p, v, __ATOMIC_RELAXED, __HIP_MEMORY_SCOPE_AGENT); }
__device__ __forceinline__ unsigned xb_xcc_id() { return (unsigned)__builtin_amdgcn_s_getreg((3 << 11) | 20) & 0xFu; }
#define XB_SPIN(cond, bar) do { unsigned _sp = 0; while (cond) { __builtin_amdgcn_s_sleep(1); \
    if ((++_sp & 255u) == 0u) { if (xb_ld(&(bar)[XB_TMO])) break; if (_sp > XB_SPIN_CAP) { atomicAdd(&(bar)[XB_TMO], 1u); break; } } } } while (0)

struct XcdBarrier {
    unsigned* bar; unsigned x;
    volatile LAS unsigned* st;
};

__device__ __forceinline__ XcdBarrier xcd_barrier_post(unsigned* bar, volatile LAS unsigned* st) {
    XcdBarrier b; b.bar = bar; b.x = xb_xcc_id(); b.st = st;
    if (threadIdx.x == 0) (void)xb_add(&bar[XB_XCNT(b.x)], 1u);
    return b;
}
__device__ __forceinline__ void xcd_barrier_complete(unsigned* bar, unsigned x, unsigned& nloc, unsigned& nx) {
    const unsigned G = gridDim.x * gridDim.y * gridDim.z;
    unsigned sum, cnt, mine, sp = 0u;
    for (;;) {
        sum = 0u; cnt = 0u; mine = 0u;
#pragma unroll
        for (unsigned j = 0; j < 16; ++j) { const unsigned c = xb_ld(&bar[XB_XCNT(j)]); sum += c; cnt += (c > 0u) ? 1u : 0u; mine = (j == x) ? c : mine; }
        if (sum == G) break;
        __builtin_amdgcn_s_sleep(1);
        if ((++sp & 255u) == 0u) { if (xb_ld(&bar[XB_TMO])) break; if (sp > XB_SPIN_CAP) { atomicAdd(&bar[XB_TMO], 1u); break; } }
    }
    nloc = mine > 0u ? mine : 1u; nx = cnt > 0u ? cnt : 1u;
}

__device__ __forceinline__ void xcd_barrier(const XcdBarrier& b) {
    asm volatile("s_waitcnt vmcnt(0)" ::: "memory");
    __syncthreads();
    if (threadIdx.x == 0) {
        unsigned* bar = b.bar;
        __builtin_amdgcn_s_waitcnt(0);
        unsigned nloc = b.st[0], nx = b.st[1];
        if (nloc == 0u) { xcd_barrier_complete(bar, b.x, nloc, nx); b.st[0] = nloc; b.st[1] = nx; }
        const unsigned old = xb_add(&bar[XB_XSUB(b.x)], 1u);
        const unsigned gen = old / nloc;
        if (old + 1u == (gen + 1u) * nloc) {
            __builtin_amdgcn_fence(__ATOMIC_RELEASE, "agent");
            asm volatile("s_waitcnt vmcnt(0)" ::: "memory");
            const unsigned og = xb_add(&bar[XB_TOP], 1u);
            const unsigned tg = og / nx;
            if (og + 1u == (tg + 1u) * nx) xb_add(&bar[XB_TOPGEN], 1u);
            else XB_SPIN(xb_ld(&bar[XB_TOPGEN]) == tg, bar);
            __builtin_amdgcn_fence(__ATOMIC_ACQUIRE, "agent");
            xb_add(&bar[XB_XGEN(b.x)], 1u);
            asm volatile("s_waitcnt vmcnt(0)" ::: "memory");
        } else {
            XB_SPIN(xb_ld(&bar[XB_XGEN(b.x)]) == gen, bar);
            __builtin_amdgcn_fence(__ATOMIC_ACQUIRE, "agent");
            asm volatile("s_waitcnt vmcnt(0)" ::: "memory");
        }
    }
    __syncthreads();
}

__global__ void __launch_bounds__(NTHR, 2) fwd_megakernel(Args a) {
    extern __shared__ __attribute__((aligned(16))) unsigned char lds_raw[];
    LAS unsigned char* lds = (LAS unsigned char*)lds_raw;
    cg::grid_group grid = cg::this_grid();
    const int G = gridDim.x, bid = blockIdx.x;
    const int vcu = (G % 8 == 0) ? (bid % 8) * (G / 8) + bid / 8 : bid;
    const int NGW = G * NWAVES, GT = G * NTHR;
    unsigned char* ws = a.ws;
    bf16* XN = (bf16*)(ws + WS_XN); bf16* Hb = (bf16*)(ws + WS_H); bf16* PROJ = (bf16*)(ws + WS_H); bf16* Yb = (bf16*)(ws + WS_Y); bf16* Ub = (bf16*)(ws + WS_U);
    float* BC = (float*)(ws + WS_BC); float* DEC = (float*)(ws + WS_DEC);
    bf16* XB = (bf16*)(ws + WS_XB);
    { volatile LAS unsigned* z = (volatile LAS unsigned*)(lds + 131072); if (threadIdx.x < 64) z[threadIdx.x] = 0u; }
    __syncthreads();
    const XcdBarrier xbar = xcd_barrier_post((unsigned*)(ws + WS_CTL), (volatile LAS unsigned*)(lds + 131072 + 64));
#define GRID_SYNC() xcd_barrier(xbar)
#define GRID_SYNC0() grid.sync()
#define PHASE_IDS int tid = threadIdx.x; asm volatile("" : "+v"(tid)); const int lane = tid & 63, wave = __builtin_amdgcn_readfirstlane(tid >> 6), gw = vcu * NWAVES + wave, gtid = bid * NTHR + tid; (void)lane; (void)wave; (void)gw; (void)gtid;

#pragma unroll 1
    for (int l = 0; l < 2; ++l) {
        if (l == 0) { PHASE_IDS cast_phase(a.in[0], XB, gw, NGW, lane); }
        { PHASE_IDS convert_phase(&a, l, lds, gw, NGW, wave, lane, gtid, GT); }
#pragma unroll 1
        for (int f = 0; f < 2; ++f) {
            if (l == 0 && f == 0) GRID_SYNC0(); { PHASE_IDS norm_phase(XB, (f == 0 ? a.in[1] : a.in[12]) + (size_t)l * D, XN, gw, NGW, lane); }
            GRID_SYNC();
            { pg8::Gemm g{XN, (const bf16*)(ws + (f == 0 ? WS_F1UP : WS_F2UP)), T, NUP, D}; pg8::StaticOrder S; S.init(T, NUP, G, bid);
              pg8::EpiSwiglu E{Hb, FF};
              _Pragma("unroll 1") for (int rep = 0; rep < REP_GEMM; ++rep)
              pg8::gemm_phase<pg8::EpiSwiglu, pg8::StaticOrder, true, true>(lds, g, S, E); }
            GRID_SYNC();
            { pg8::Gemm g{Hb, (const bf16*)(ws + (f == 0 ? WS_F1DN : WS_F2DN)), T, D, FF}; pg8::StaticOrder S; S.init(T, D, G, bid);
              pg8::EpiResid E{XB, D, 0.5f};
              pg8::gemm_phase<pg8::EpiResid, pg8::StaticOrder, true, true>(lds, g, S, E); }
            GRID_SYNC();
            if (f == 0) {
                { PHASE_IDS norm_phase(XB, a.in[5] + (size_t)l * D, XN, gw, NGW, lane); }
                GRID_SYNC();
                { pg8::Gemm g{XN, (const bf16*)(ws + WS_WIN), T, C_ZL, D}; pg8::StaticOrder S; S.init(T, C_ZL, G, bid);
                  pg8::EpiStoreBf16 E{PROJ, NIN};
                  _Pragma("unroll 1") for (int rep = 0; rep < REP_GEMM; ++rep)
                  pg8::gemm_phase<pg8::EpiStoreBf16, pg8::StaticOrder, true, true>(lds, g, S, E); }
                GRID_SYNC();
#pragma unroll 1
                for (int c = bid; c < NCH; c += G) { gla_zl_chunk(XN, (const bf16*)(ws + WS_WIN) + (size_t)C_ZL * D, lds, c, threadIdx.x);
                    gla1_chunk(PROJ, a.in[8] + (size_t)l * RANK * DQK, a.in[9] + (size_t)l * DQK, Ub, BC, DEC, lds, c, threadIdx.x); }
                GRID_SYNC();
                { PHASE_IDS if (tid < 256) scan_phase(Ub, Ub, DEC, bid, G, tid); else conv_phase(PROJ, a.in[7] + (size_t)l * 3 * DCONV, Yb, bid * 256 + (tid - 256), G * 256); }
                GRID_SYNC();
#pragma unroll 1
                for (int id = bid; id < REP_GLA * NCH * NH; id += G) gla3_tile(PROJ, Ub, BC, a.in[10] + (size_t)l * HV, Yb, lds, (id >> 2) & 255, id & 3, threadIdx.x);
                GRID_SYNC();
                { pg8::Gemm g{Yb, (const bf16*)(ws + WS_WOUT), T, D, D}; pg8::StaticOrder S; S.init(T, D, G, bid);
                  pg8::EpiResid E{XB, D, 1.0f};
                  pg8::gemm_phase<pg8::EpiResid, pg8::StaticOrder, true, true>(lds, g, S, E); }
                GRID_SYNC();
            }
        }
    }
    { PHASE_IDS final_norm_phase(XB, a.in[16], a.out, gw, NGW, lane); }
}

extern "C" void kernel_launch(void* const* d_in, const int* in_sizes, int n_in, void* d_out, int out_size, void* d_ws, size_t ws_size, hipStream_t stream) {
    static int grid = 0;
    if (grid == 0) {
        if (n_in != 17 || out_size != T * D || ws_size < WS_END) { fprintf(stderr, "kernel_launch: unexpected sizes n_in %d out %d ws %zu\n", n_in, out_size, ws_size); grid = -1; return; }
        int dev = 0, cus = 0, per_cu = 0;
        hipGetDevice(&dev); hipDeviceGetAttribute(&cus, hipDeviceAttributeMultiprocessorCount, dev);
        if (hipFuncSetAttribute((const void*)fwd_megakernel, hipFuncAttributeMaxDynamicSharedMemorySize, LDS_BYTES) != hipSuccess) { fprintf(stderr, "kernel_launch: hipFuncSetAttribute failed\n"); grid = -1; return; }
        if (hipOccupancyMaxActiveBlocksPerMultiprocessor(&per_cu, (const void*)fwd_megakernel, NTHR, LDS_BYTES) != hipSuccess || per_cu < 1) per_cu = 1;
        (void)hipGetLastError();
        grid = cus * per_cu;
    }
    if (grid < 0) return;
    Args a{};
    for (int i = 0; i < 17; ++i) a.in[i] = (const float*)d_in[i];
    a.out = (float*)d_out; a.ws = (unsigned char*)d_ws;
    if (hipMemsetAsync((char*)d_ws + WS_CTL, 0, CTL_BYTES, stream) != hipSuccess) { fprintf(stderr, "kernel_launch: memset failed\n"); return; }
    void* args[] = {&a};
    hipError_t e = hipLaunchCooperativeKernel((const void*)fwd_megakernel, dim3(grid), dim3(NTHR), args, LDS_BYTES, stream);
    if (e != hipSuccess) fprintf(stderr, "cooperative launch failed: %s (grid %d)\n", hipGetErrorString(e), grid);
}
```
